# Optimizing an MI355X kernel written in HIP

```python
import jax
import jax.numpy as jnp
from jax import lax
import numpy as np

D_MODEL = 1024
BATCH = 2
SEQ = 8192
DEPTH = 1

EPS = 1e-6
SSD_HEADS = 8
SSD_HEAD_DIM = 64
SSD_WIDTH = SSD_HEADS * SSD_HEAD_DIM
SSD_GROUPS = 2
SSD_STATE = 128
SSD_CONV = 4
SSD_CHUNK = 128
SSD_CONV_DIM = SSD_WIDTH + 2 * SSD_GROUPS * SSD_STATE
MLA_HEADS = 8
MLA_Q_RANK = 256
MLA_KV_RANK = 128
MLA_NOPE = 64
MLA_ROPE = 32
MLA_V = 64
MLA_QK = MLA_NOPE + MLA_ROPE
MLA_WIDTH = MLA_HEADS * MLA_V
ROPE_THETA = 10000.0
ATTN_BLOCK = 128
MIX_WIDTH = SSD_WIDTH + MLA_WIDTH
IN_SPLITS = (SSD_WIDTH, SSD_CONV_DIM, SSD_HEADS, MLA_Q_RANK, MLA_KV_RANK, MLA_ROPE)
IN_WIDTH = SSD_WIDTH + SSD_CONV_DIM + SSD_HEADS + MLA_Q_RANK + MLA_KV_RANK + MLA_ROPE
N_EXPERTS = 32
TOP_K = 4
D_FF = 1024
SWIGLU_LIMIT = 7.0
SWIGLU_ALPHA = 1.702
MOE_BLOCK = 128

kernel_name = 'hybrid_ssd_mla_moe_layer'


def _split_points(widths):
    return tuple(int(v) for v in np.cumsum(widths)[:-1])


def rms_norm(x, g):
    xf = x.astype(jnp.float32)
    y = xf * lax.rsqrt(jnp.mean(xf * xf, axis=-1, keepdims=True) + EPS)
    return (y * g.astype(jnp.float32)).astype(x.dtype)


def causal_depthwise_conv(u, w, b):
    ch = u.shape[-1]
    out = lax.conv_general_dilated(
        u, w[:, None, :].astype(u.dtype), window_strides=(1,),
        padding=((SSD_CONV - 1, 0),), dimension_numbers=('NWC', 'WIO', 'NWC'),
        feature_group_count=ch)
    return out + b.astype(u.dtype)


def ssd_chunked(x, dt, a, b_in, c_in):
    bsz, seqlen, nh, hp = x.shape
    g, n = b_in.shape[2], b_in.shape[3]
    j = nh // g
    q = SSD_CHUNK
    nc = seqlen // q
    xd = (x * dt[..., None]).reshape(bsz, nc, q, g, j, hp)
    a_dt = (dt * a).reshape(bsz, nc, q, g, j)
    bc = b_in.reshape(bsz, nc, q, g, n)
    cc = c_in.reshape(bsz, nc, q, g, n)
    a_cum = jnp.cumsum(a_dt, axis=2)
    seg = a_cum[:, :, :, None] - a_cum[:, :, None, :]
    causal = jnp.tril(jnp.ones((q, q), dtype=bool))[None, None, :, :, None, None]
    decay = jnp.exp(jnp.where(causal, seg, -jnp.inf))
    scores = jnp.einsum('bclgn,bcsgn->bclsg', cc, bc)
    y_diag = jnp.einsum('bclsgj,bcsgjp->bclgjp', scores[..., None] * decay, xd)
    decay_to_end = jnp.exp(a_cum[:, :, -1:] - a_cum)
    states = jnp.einsum('bcsgn,bcsgj,bcsgjp->bcgjpn', bc, decay_to_end, xd)
    chunk_decay = jnp.exp(a_cum[:, :, -1])

    def step(h, inp):
        s_c, d_c = inp
        return h * d_c[..., None, None] + s_c, h

    h0 = jnp.zeros((bsz, g, j, hp, n), dtype=x.dtype)
    _, prev = lax.scan(step, h0, (jnp.swapaxes(states, 0, 1), jnp.swapaxes(chunk_decay, 0, 1)))
    prev = jnp.swapaxes(prev, 0, 1)
    y_off = jnp.einsum('bclgn,bcgjpn,bclgj->bclgjp', cc, prev, jnp.exp(a_cum))
    return (y_diag + y_off).reshape(bsz, seqlen, nh, hp)


def ssd_mixer(z, xbc, dt_raw, conv_w, conv_b, dt_bias, a_log, d_skip, norm_g):
    bsz, seqlen, _ = z.shape
    xbc = jax.nn.silu(causal_depthwise_conv(xbc, conv_w, conv_b))
    xs, bs, cs = jnp.split(xbc, _split_points((SSD_WIDTH, SSD_GROUPS * SSD_STATE, SSD_GROUPS * SSD_STATE)), axis=-1)
    xh = xs.reshape(bsz, seqlen, SSD_HEADS, SSD_HEAD_DIM).astype(jnp.float32)
    bm = bs.reshape(bsz, seqlen, SSD_GROUPS, SSD_STATE).astype(jnp.float32)
    cm = cs.reshape(bsz, seqlen, SSD_GROUPS, SSD_STATE).astype(jnp.float32)
    dt = jax.nn.softplus(dt_raw.astype(jnp.float32) + dt_bias.astype(jnp.float32))
    a = -jnp.exp(a_log.astype(jnp.float32))
    y = ssd_chunked(xh, dt, a, bm, cm) + d_skip.astype(jnp.float32)[:, None] * xh
    y = y.reshape(bsz, seqlen, SSD_WIDTH) * jax.nn.silu(z.astype(jnp.float32))
    yg = y.reshape(bsz, seqlen, SSD_GROUPS, SSD_WIDTH // SSD_GROUPS)
    yg = yg * lax.rsqrt(jnp.mean(yg * yg, axis=-1, keepdims=True) + EPS)
    y = yg.reshape(bsz, seqlen, SSD_WIDTH) * norm_g.astype(jnp.float32)
    return y.astype(z.dtype)


def rope_tables(positions):
    inv_freq = ROPE_THETA ** (-jnp.arange(0, MLA_ROPE, 2, dtype=jnp.float32) / MLA_ROPE)
    ang = positions.astype(jnp.float32)[..., None] * inv_freq
    return jnp.cos(ang), jnp.sin(ang)


def apply_rope(x, cos, sin):
    x1, x2 = jnp.split(x, 2, axis=-1)
    cos = cos.astype(x.dtype)
    sin = sin.astype(x.dtype)
    return jnp.concatenate([x1 * cos - x2 * sin, x2 * cos + x1 * sin], axis=-1)


def mla_mixer(c_q, c_kv, k_rope, positions, q_norm_g, w_uq, kv_norm_g, w_ukv):
    bsz, seqlen, _ = c_q.shape
    q = (rms_norm(c_q, q_norm_g) @ w_uq).reshape(bsz, seqlen, MLA_HEADS, MLA_QK)
    q_nope, q_rope = jnp.split(q, (MLA_NOPE,), axis=-1)
    kv = (rms_norm(c_kv, kv_norm_g) @ w_ukv).reshape(bsz, seqlen, MLA_HEADS, MLA_NOPE + MLA_V)
    k_nope, v = jnp.split(kv, (MLA_NOPE,), axis=-1)
    cos, sin = rope_tables(positions)
    q_rope = apply_rope(q_rope, cos[:, :, None, :], sin[:, :, None, :])
    k_rope = apply_rope(k_rope, cos, sin)
    scale = MLA_QK ** -0.5
    q_nope = q_nope * scale
    q_rope = q_rope * scale
    key_pos = jnp.arange(seqlen)

    def block(i):
        start = i * ATTN_BLOCK
        qn = lax.dynamic_slice_in_dim(q_nope, start, ATTN_BLOCK, axis=1)
        qr = lax.dynamic_slice_in_dim(q_rope, start, ATTN_BLOCK, axis=1)
        s = (jnp.einsum('bqhd,bkhd->bhqk', qn, k_nope)
             + jnp.einsum('bqhr,bkr->bhqk', qr, k_rope)).astype(jnp.float32)
        q_pos = start + jnp.arange(ATTN_BLOCK)
        mask = key_pos[None, :] <= q_pos[:, None]
        p = jax.nn.softmax(jnp.where(mask, s, -jnp.inf), axis=-1).astype(v.dtype)
        return jnp.einsum('bhqk,bkhd->bqhd', p, v)

    o = lax.map(block, jnp.arange(seqlen // ATTN_BLOCK))
    return jnp.transpose(o, (1, 0, 2, 3, 4)).reshape(bsz, seqlen, MLA_WIDTH)


def moe_ffn(h, w_router, b_router, w_gate_up, b_gate_up, w_down, b_down):
    bsz, seqlen, d = h.shape
    t = bsz * seqlen
    xf = h.reshape(t, d)
    logits = (xf @ w_router + b_router).astype(jnp.float32)
    top_vals, top_idx = lax.top_k(logits, TOP_K)
    gates = jax.nn.softmax(top_vals, axis=-1)
    na = t * TOP_K
    flat_e = top_idx.reshape(na).astype(jnp.int32)
    flat_tok = jnp.repeat(jnp.arange(t, dtype=jnp.int32), TOP_K)
    flat_w = gates.reshape(na)
    order = jnp.argsort(flat_e)
    sorted_e = flat_e[order]
    counts = jnp.zeros((N_EXPERTS,), jnp.int32).at[flat_e].add(1)
    padded = ((counts + MOE_BLOCK - 1) // MOE_BLOCK) * MOE_BLOCK
    start_unpad = jnp.cumsum(counts) - counts
    end_pad = jnp.cumsum(padded)
    start_pad = end_pad - padded
    dest = start_pad[sorted_e] + (jnp.arange(na, dtype=jnp.int32) - start_unpad[sorted_e])
    n_slots = na + N_EXPERTS * MOE_BLOCK
    n_blocks = n_slots // MOE_BLOCK
    slot_tok = jnp.full((n_slots,), t, jnp.int32).at[dest].set(flat_tok[order])
    slot_w = jnp.zeros((n_slots,), jnp.float32).at[dest].set(flat_w[order])
    block_start = jnp.arange(n_blocks, dtype=jnp.int32) * MOE_BLOCK
    block_e = jnp.minimum(jnp.sum(block_start[:, None] >= end_pad[None, :], axis=1), N_EXPERTS - 1)
    x_pad = jnp.concatenate([xf, jnp.zeros((1, d), xf.dtype)], axis=0)
    xs = x_pad[slot_tok].reshape(n_blocks, MOE_BLOCK, d)

    def expert_block(args):
        xb, e = args
        gu = xb @ w_gate_up[e] + b_gate_up[e]
        gate, up = jnp.split(gu, 2, axis=-1)
        gate = jnp.minimum(gate, SWIGLU_LIMIT)
        up = jnp.clip(up, -SWIGLU_LIMIT, SWIGLU_LIMIT)
        glu = gate * jax.nn.sigmoid(SWIGLU_ALPHA * gate)
        return ((up + 1.0) * glu) @ w_down[e] + b_down[e]

    ys = lax.map(expert_block, (xs, block_e)).reshape(n_slots, d)
    ys = ys * slot_w[:, None].astype(ys.dtype)
    out = jnp.zeros((t + 1, d), ys.dtype).at[slot_tok].add(ys)[:t]
    return out.reshape(bsz, seqlen, d)


def setup_inputs(seed: int = 0) -> dict:
    key = jax.random.key(seed)
    ks = jax.random.split(key, 32)
    f32 = jnp.float32

    def nrm(k, shape, scale):
        return jax.random.normal(k, shape, f32) * scale

    def gain(k, shape):
        return 1.0 + 0.02 * jax.random.normal(k, shape, f32)

    x = jax.random.normal(ks[0], (BATCH, SEQ, D_MODEL), f32)
    offsets = jax.random.randint(ks[1], (BATCH, 1), 0, 1024, dtype=jnp.int32)
    positions = jnp.arange(SEQ, dtype=jnp.int32)[None, :] + offsets
    dt0 = jnp.exp(jax.random.uniform(ks[6], (DEPTH, SSD_HEADS), f32, np.log(1e-3), np.log(1e-1)))
    dt_bias = dt0 + jnp.log(-jnp.expm1(-dt0))
    a_log = jnp.log(jax.random.uniform(ks[7], (DEPTH, SSD_HEADS), f32, 1.0, 16.0))
    return {
        'x': x,
        'positions': positions,
        'norm_mix_g': gain(ks[2], (DEPTH, D_MODEL)),
        'w_in': nrm(ks[3], (DEPTH, D_MODEL, IN_WIDTH), D_MODEL ** -0.5),
        'conv_w': nrm(ks[4], (DEPTH, SSD_CONV, SSD_CONV_DIM), SSD_CONV ** -0.5),
        'conv_b': nrm(ks[5], (DEPTH, SSD_CONV_DIM), 0.01),
        'dt_bias': dt_bias,
        'a_log': a_log,
        'd_skip': 1.0 + 0.1 * jax.random.normal(ks[8], (DEPTH, SSD_HEADS), f32),
        'ssd_norm_g': gain(ks[9], (DEPTH, SSD_WIDTH)),
        'q_norm_g': gain(ks[10], (DEPTH, MLA_Q_RANK)),
        'w_uq': nrm(ks[11], (DEPTH, MLA_Q_RANK, MLA_HEADS * MLA_QK), MLA_Q_RANK ** -0.5),
        'kv_norm_g': gain(ks[12], (DEPTH, MLA_KV_RANK)),
        'w_ukv': nrm(ks[13], (DEPTH, MLA_KV_RANK, MLA_HEADS * (MLA_NOPE + MLA_V)), MLA_KV_RANK ** -0.5),
        'w_out': nrm(ks[14], (DEPTH, MIX_WIDTH, D_MODEL), MIX_WIDTH ** -0.5),
        'norm_ffn_g': gain(ks[15], (DEPTH, D_MODEL)),
        'w_router': nrm(ks[16], (DEPTH, D_MODEL, N_EXPERTS), D_MODEL ** -0.5),
        'b_router': nrm(ks[17], (DEPTH, N_EXPERTS), 0.01),
        'w_gate_up': nrm(ks[18], (DEPTH, N_EXPERTS, D_MODEL, 2 * D_FF), D_MODEL ** -0.5),
        'b_gate_up': nrm(ks[19], (DEPTH, N_EXPERTS, 2 * D_FF), 0.01),
        'w_down': nrm(ks[20], (DEPTH, N_EXPERTS, D_FF, D_MODEL), D_FF ** -0.5),
        'b_down': nrm(ks[21], (DEPTH, N_EXPERTS, D_MODEL), 0.01),
        'norm_final_g': gain(ks[22], (D_MODEL,)),
    }


def reference(x, positions, norm_mix_g, w_in, conv_w, conv_b, dt_bias, a_log, d_skip, ssd_norm_g,
              q_norm_g, w_uq, kv_norm_g, w_ukv, w_out, norm_ffn_g, w_router, b_router,
              w_gate_up, b_gate_up, w_down, b_down, norm_final_g):
    for l in range(DEPTH):
        h = rms_norm(x, norm_mix_g[l])
        proj = h @ w_in[l]
        z, xbc, dt_raw, c_q, c_kv, k_rope = jnp.split(proj, _split_points(IN_SPLITS), axis=-1)
        y_ssd = ssd_mixer(z, xbc, dt_raw, conv_w[l], conv_b[l], dt_bias[l], a_log[l], d_skip[l], ssd_norm_g[l])
        y_mla = mla_mixer(c_q, c_kv, k_rope, positions, q_norm_g[l], w_uq[l], kv_norm_g[l], w_ukv[l])
        x = x + jnp.concatenate([y_ssd, y_mla], axis=-1) @ w_out[l]
        h = rms_norm(x, norm_ffn_g[l])
        x = x + moe_ffn(h, w_router[l], b_router[l], w_gate_up[l], b_gate_up[l], w_down[l], b_down[l])
    return rms_norm(x, norm_final_g)
```

```cpp
#include <hip/hip_runtime.h>
#include <cstdio>
#include <cstdint>

typedef unsigned short bf16_t;
typedef unsigned u32;
typedef float f32x4 __attribute__((ext_vector_type(4)));
typedef unsigned u32x4 __attribute__((ext_vector_type(4)));
typedef unsigned u32x2 __attribute__((ext_vector_type(2)));
#define DI __device__ __forceinline__

constexpr int NB = 2, SEQ = 8192, DM = 1024, NTOK = NB * SEQ;
constexpr int IN_W = 1960;
constexpr int NH = 8, HP = 64, NG = 2, NST = 128, CHUNK = 128;
constexpr int QK = 96, NOPE = 64, ROPE = 32, VD = 64;
constexpr int NE = 32, TOPK = 4, DFF = 1024;
constexpr float EPS = 1e-6f;
constexpr float QSCALE = 0.14724444602590306f;
constexpr int SLOT_ROWS = NTOK * TOPK + NE * 256;

constexpr size_t MiB = 1u << 20;
constexpr size_t WS_CTL = 0, CTL_BYTES = 1 * MiB;
constexpr size_t WS_ROPEC = 1 * MiB, WS_ROPES = 2 * MiB;
constexpr size_t WS_H = 208 * MiB;
constexpr size_t WS_PROJ = 240 * MiB;
constexpr size_t WS_CQ = 288 * MiB;
constexpr size_t WS_CKV = 296 * MiB;
constexpr size_t WS_DT = 300 * MiB;
constexpr size_t WS_PARTQ = 301 * MiB;
constexpr size_t WS_PARTKV = 303 * MiB;
constexpr size_t WS_Q = 304 * MiB;
constexpr size_t WS_K = 328 * MiB;
constexpr size_t WS_VT = 352 * MiB;
constexpr size_t WS_Y = 368 * MiB;
constexpr size_t WS_STATES = 400 * MiB;
constexpr size_t WS_CD = 432 * MiB;
constexpr size_t WS_YCAT = 434 * MiB;
constexpr size_t WS_X1 = 466 * MiB;
constexpr size_t WS_H2 = 530 * MiB;
constexpr size_t WS_TOKE = 562 * MiB;
constexpr size_t WS_TOKP = WS_TOKE + 256 * 1024;
constexpr size_t WS_LIST = 563 * MiB;
constexpr size_t WS_LISTG = 565 * MiB;
constexpr size_t WS_ACT = 568 * MiB;
constexpr size_t WS_YS = 712 * MiB;
constexpr size_t WS_XBCC = 712 * MiB;
constexpr size_t WS_END = 856 * MiB;
constexpr int CW_CNT = 64;

DI float bf2f(bf16_t v) { return __uint_as_float((u32)v << 16); }
DI u32 f2bf(float f) { u32 u = __float_as_uint(f); return (u + 0x7fffu + ((u >> 16) & 1u)) >> 16; }
DI u32 pk2(float lo, float hi) { return f2bf(lo) | (f2bf(hi) << 16); }
DI void store8(bf16_t* p, const float (&v)[8]) { u32x4 w; w.x = pk2(v[0], v[1]); w.y = pk2(v[2], v[3]); w.z = pk2(v[4], v[5]); w.w = pk2(v[6], v[7]); *(u32x4*)p = w; }
DI void load8(const bf16_t* p, float (&v)[8]) { const u32x4 w = *(const u32x4*)p;
    v[0] = __uint_as_float(w.x << 16); v[1] = __uint_as_float(w.x & 0xffff0000u); v[2] = __uint_as_float(w.y << 16); v[3] = __uint_as_float(w.y & 0xffff0000u);
    v[4] = __uint_as_float(w.z << 16); v[5] = __uint_as_float(w.z & 0xffff0000u); v[6] = __uint_as_float(w.w << 16); v[7] = __uint_as_float(w.w & 0xffff0000u); }
DI float wave_sum(float v) {
#pragma unroll
    for (int o = 1; o < 64; o <<= 1) v += __shfl_xor(v, o);
    return v;
}
DI float silu(float v) { return v / (1.f + __expf(-v)); }
DI size_t qk_off(int b, int h, int s, int dc) { return ((((size_t)(b * NH + h) * 128 + (s >> 6)) * 12 + dc) * 64 + (s & 63)) * 8; }
DI size_t vt_off(int b, int h, int s, int d) {
    const int sl = s & 63, g16 = sl >> 4, w = sl & 15, a = (w >> 3) & 1, bb = (w >> 2) & 1, c = w & 3;
    return ((((size_t)(b * NH + h) * 128 + (s >> 6)) * 8 + (2 * g16 + bb)) * 64 + d) * 8 + 4 * a + c;
}
__host__ __device__ inline int inproj_src_col(int c) {
    if (c < 1536) return c;
    if (c < 1792) return 1544 + (c - 1536);
    if (c < 1920) return 1800 + (c - 1792);
    if (c < 1952) { const int i = c - 1920; return 1928 + (i >> 1) + ((i & 1) ? 16 : 0); }
    if (c < 1960) return 1536 + (c - 1952);
    return -1;
}
__host__ __device__ inline int q_src_col(int c) { const int h = c / 96, r = c - h * 96; if (r < 64) return h * 96 + r; const int i = r - 64; return h * 96 + 64 + (i >> 1) + ((i & 1) ? 16 : 0); }

__device__ const double INVF2PI[16] = {0.15915494309189535, 0.08949940160889101, 0.050329212104487035, 0.0283021958306234, 0.015915494309189534, 0.0089499401608891, 0.005032921210448704, 0.00283021958306234,
                                      0.0015915494309189536, 0.0008949940160889102, 0.0005032921210448703, 0.00028302195830623395, 0.00015915494309189535, 8.9499401608891e-05, 5.0329212104487035e-05, 2.83021958306234e-05};

__global__ __launch_bounds__(256) void k_rope_table(const int* __restrict__ pos, float* __restrict__ rc, float* __restrict__ rs) {
    const int idx = blockIdx.x * 256 + threadIdx.x; if (idx >= NTOK * 16) return;
    const int tok = idx >> 4, i = idx & 15;
    double t = (double)pos[tok] * INVF2PI[i]; t -= floor(t);
    const float fr = (float)t;
    rc[idx] = __builtin_amdgcn_cosf(fr); rs[idx] = __builtin_amdgcn_sinf(fr);
}
__global__ __launch_bounds__(256) void k_rmsnorm_bf16(const float* __restrict__ x, const float* __restrict__ g, bf16_t* __restrict__ out) {
    const int row = blockIdx.x * 4 + (threadIdx.x >> 6), lane = threadIdx.x & 63;
    const f32x4* xr = (const f32x4*)(x + (size_t)row * DM) + lane; f32x4 v[4]; float ss = 0.f;
#pragma unroll
    for (int j = 0; j < 4; ++j) { v[j] = xr[64 * j]; ss += v[j].x * v[j].x + v[j].y * v[j].y + v[j].z * v[j].z + v[j].w * v[j].w; }
    const float r = rsqrtf(wave_sum(ss) * (1.f / DM) + EPS);
#pragma unroll
    for (int j = 0; j < 4; ++j) { const f32x4 gg = ((const f32x4*)g)[lane + 64 * j]; u32x2 w; w.x = pk2(v[j].x * r * gg.x, v[j].y * r * gg.y); w.y = pk2(v[j].z * r * gg.z, v[j].w * r * gg.w);
        *(u32x2*)(out + (size_t)row * DM + 4 * (lane + 64 * j)) = w; }
}

struct EpiInproj {
    bf16_t* proj; bf16_t* cq; bf16_t* ckv; float* dt; float* partq; float* partkv; bf16_t* kbuf; const float* ropec; const float* ropes;
    DI float rowctx(int) const { return 1.f; }
    DI void operator()(int row, int col0, const float (&v)[8], float) const {
        if (col0 < 1536) { store8(proj + (size_t)row * 1536 + col0, v); }
        else if (col0 < 1792) { store8(cq + (size_t)row * 256 + (col0 - 1536), v); float s = 0.f;
#pragma unroll
            for (int j = 0; j < 8; ++j) s += v[j] * v[j];
            partq[(size_t)row * 32 + ((col0 - 1536) >> 3)] = s; }
        else if (col0 < 1920) { store8(ckv + (size_t)row * 128 + (col0 - 1792), v); float s = 0.f;
#pragma unroll
            for (int j = 0; j < 8; ++j) s += v[j] * v[j];
            partkv[(size_t)row * 16 + ((col0 - 1792) >> 3)] = s; }
        else if (col0 < 1952) { const int i0 = (col0 - 1920) >> 1; float o[8];
#pragma unroll
            for (int m = 0; m < 4; ++m) { const float c = ropec[(size_t)row * 16 + i0 + m], s = ropes[(size_t)row * 16 + i0 + m]; o[2 * m] = v[2 * m] * c - v[2 * m + 1] * s; o[2 * m + 1] = v[2 * m + 1] * c + v[2 * m] * s; }
            const int b = row >> 13, s_ = row & (SEQ - 1), dc = 8 + ((col0 - 1920) >> 3);
#pragma unroll
            for (int h = 0; h < NH; ++h) store8(kbuf + qk_off(b, h, s_, dc), o); }
        else if (col0 == 1952) { *(f32x4*)(dt + (size_t)row * 8) = (f32x4){v[0], v[1], v[2], v[3]}; *(f32x4*)(dt + (size_t)row * 8 + 4) = (f32x4){v[4], v[5], v[6], v[7]}; }
    }
};
DI float part_sum(const float* p, int n4) { float s = 0.f; for (int i = 0; i < n4; ++i) { const f32x4 t = ((const f32x4*)p)[i]; s += (t.x + t.y) + (t.z + t.w); } return s; }
struct EpiQ {
    bf16_t* q; const float* partq; const float* ropec; const float* ropes;
    DI float rowctx(int row) const { return rsqrtf(part_sum(partq + (size_t)row * 32, 8) * (1.f / 256.f) + EPS) * QSCALE; }
    DI void operator()(int row, int col0, const float (&v)[8], float rs) const {
        const int h = col0 / 96, c = col0 - h * 96; float o[8];
        if (c < 64) {
#pragma unroll
            for (int j = 0; j < 8; ++j) o[j] = v[j] * rs;
        } else { const int i0 = (c - 64) >> 1;
#pragma unroll
            for (int m = 0; m < 4; ++m) { const float cc = ropec[(size_t)row * 16 + i0 + m], ss = ropes[(size_t)row * 16 + i0 + m]; const float a = v[2 * m] * rs, b = v[2 * m + 1] * rs; o[2 * m] = a * cc - b * ss; o[2 * m + 1] = b * cc + a * ss; } }
        store8(q + qk_off(row >> 13, h, row & (SEQ - 1), c >> 3), o);
    }
};
struct EpiKn {
    bf16_t* k; const float* partkv;
    DI float rowctx(int row) const { return rsqrtf(part_sum(partkv + (size_t)row * 16, 4) * (1.f / 128.f) + EPS); }
    DI void operator()(int row, int col0, const float (&v)[8], float rs) const {
        const int h = col0 >> 6, c = col0 & 63; float o[8];
#pragma unroll
        for (int j = 0; j < 8; ++j) o[j] = v[j] * rs;
        store8(k + qk_off(row >> 13, h, row & (SEQ - 1), c >> 3), o);
    }
};
struct EpiVt {
    bf16_t* vt; const float* partkv;
    DI float rowctx(int) const { return 1.f; }
    DI void operator()(int row, int tok0, const float (&v)[8], float) const {
        const int h = row >> 6, d = row & 63; float o[8];
#pragma unroll
        for (int j = 0; j < 8; ++j) o[j] = v[j] * rsqrtf(part_sum(partkv + (size_t)(tok0 + j) * 16, 4) * (1.f / 128.f) + EPS);
        const size_t o0 = vt_off(tok0 >> 13, h, tok0 & (SEQ - 1), d), o1 = vt_off(tok0 >> 13, h, (tok0 & (SEQ - 1)) + 4, d);
        u32x2 w0, w1; w0.x = pk2(o[0], o[1]); w0.y = pk2(o[2], o[3]); w1.x = pk2(o[4], o[5]); w1.y = pk2(o[6], o[7]);
        *(u32x2*)(vt + o0) = w0; *(u32x2*)(vt + o1) = w1;
    }
};
struct EpiOut {
    const float* x; float* x1;
    DI float rowctx(int) const { return 1.f; }
    DI void operator()(int row, int col0, const float (&v)[8], float) const {
        const f32x4 a = *(const f32x4*)(x + (size_t)row * DM + col0), b = *(const f32x4*)(x + (size_t)row * DM + col0 + 4);
        *(f32x4*)(x1 + (size_t)row * DM + col0) = (f32x4){a.x + v[0], a.y + v[1], a.z + v[2], a.w + v[3]};
        *(f32x4*)(x1 + (size_t)row * DM + col0 + 4) = (f32x4){b.x + v[4], b.y + v[5], b.z + v[6], b.w + v[7]};
    }
};
struct EpiGlu {
    bf16_t* act; const float* bgu; int e, base;
    DI void operator()(int r, int f0, const float (&g)[8], const float (&u)[8]) const {
        float o[8];
#pragma unroll
        for (int j = 0; j < 8; ++j) { float gg = g[j] + bgu[(size_t)e * 2048 + f0 + j], uu = u[j] + bgu[(size_t)e * 2048 + 1024 + f0 + j];
            gg = fminf(gg, 7.f); uu = fminf(fmaxf(uu, -7.f), 7.f); const float glu = gg / (1.f + __expf(-1.702f * gg)); o[j] = (uu + 1.f) * glu; }
        store8(act + (size_t)(base + r) * DFF + f0, o);
    }
};
struct EpiDown {
    bf16_t* ys; const float* bd; const float* listg; int e, base, cnt;
    DI void operator()(int r, int c0, const float (&v)[8]) const {
        const float gw = r < cnt ? listg[(size_t)e * NTOK + r] : 0.f; float o[8];
#pragma unroll
        for (int j = 0; j < 8; ++j) o[j] = (v[j] + bd[(size_t)e * DM + c0 + j]) * gw;
        store8(ys + (size_t)(base + r) * DM + c0, o);
    }
};

template <class AF, class BF, class EF>
__global__ __launch_bounds__(256) void naive_gemm(int K, AF af, BF bf, EF ef) {
    __shared__ float As[16][68]; __shared__ float Bs[16][132];
    const int tid = threadIdx.x, ty = tid >> 4, tx = tid & 15, row0 = blockIdx.y * 64, col0 = blockIdx.x * 128;
    float acc[4][8];
#pragma unroll
    for (int i = 0; i < 4; ++i)
#pragma unroll
        for (int j = 0; j < 8; ++j) acc[i][j] = 0.f;
    for (int k0 = 0; k0 < K; k0 += 16) {
#pragma unroll
        for (int i = 0; i < 4; ++i) { const int idx = tid + i * 256, m = idx >> 4, k = idx & 15; As[k][m] = af(row0 + m, k0 + k); }
#pragma unroll
        for (int i = 0; i < 8; ++i) { const int idx = tid + i * 256, k = idx >> 7, n = idx & 127; Bs[k][n] = bf(k0 + k, col0 + n); }
        __syncthreads();
#pragma unroll
        for (int k = 0; k < 16; ++k) { float a[4], b[8];
#pragma unroll
            for (int i = 0; i < 4; ++i) a[i] = As[k][ty * 4 + i];
#pragma unroll
            for (int j = 0; j < 8; ++j) b[j] = Bs[k][tx * 8 + j];
#pragma unroll
            for (int i = 0; i < 4; ++i)
#pragma unroll
                for (int j = 0; j < 8; ++j) acc[i][j] += a[i] * b[j]; }
        __syncthreads();
    }
#pragma unroll
    for (int i = 0; i < 4; ++i) { const int row = row0 + ty * 4 + i; ef(row, col0 + tx * 8, acc[i], ef.rowctx(row)); }
}
struct ABf16 { const bf16_t* p; int ld; int pad; DI float operator()(int m, int k) const { return bf2f(p[(size_t)m * ld + k]); } };
struct BInproj { const float* w; DI float operator()(int k, int n) const { const int s = inproj_src_col(n); return s >= 0 ? w[(size_t)k * IN_W + s] : 0.f; } };
struct BUq { const float* w; const float* g; DI float operator()(int k, int n) const { return g[k] * w[(size_t)k * 768 + q_src_col(n)]; } };
struct BKn { const float* w; const float* g; DI float operator()(int k, int n) const { return g[k] * w[(size_t)k * 1024 + (n >> 6) * 128 + (n & 63)]; } };
struct AVw { const float* w; const float* g; DI float operator()(int m, int k) const { return g[k] * w[(size_t)k * 1024 + (m >> 6) * 128 + 64 + (m & 63)]; } };
struct BTok { const bf16_t* p; int ld; int pad; DI float operator()(int k, int n) const { return bf2f(p[(size_t)n * ld + k]); } };
struct BPlain { const float* w; int ld; int pad; DI float operator()(int k, int n) const { return w[(size_t)k * ld + n]; } };

DI void expert_ctx(const u32* cnt, int e, int& base, int& c, int& rows) { int b = 0; for (int i = 0; i < e; ++i) b += ((cnt[i] + 255) >> 8) << 8; base = b; c = (int)cnt[e]; rows = ((c + 255) >> 8) << 8; }
__global__ __launch_bounds__(256) void naive_moe1(const u32* __restrict__ cntp, const int* __restrict__ list, const bf16_t* __restrict__ h2, const float* __restrict__ wgu, const float* __restrict__ bgu, bf16_t* __restrict__ act) {
    __shared__ float As[16][68]; __shared__ float Bg[16][132]; __shared__ float Bu[16][132]; __shared__ int toks[64];
    const int e = blockIdx.z; int base, cnt, rows; expert_ctx(cntp, e, base, cnt, rows);
    const int tid = threadIdx.x, ty = tid >> 4, tx = tid & 15, row0 = blockIdx.y * 64, col0 = blockIdx.x * 128;
    if (row0 >= rows) return;
    if (tid < 64) { const int r = row0 + tid; toks[tid] = list[(size_t)e * NTOK + (r < cnt ? r : 0)]; }
    __syncthreads();
    float ag[4][8], au[4][8];
#pragma unroll
    for (int i = 0; i < 4; ++i)
#pragma unroll
        for (int j = 0; j < 8; ++j) { ag[i][j] = 0.f; au[i][j] = 0.f; }
    const float* w = wgu + (size_t)e * DM * 2048;
    for (int k0 = 0; k0 < DM; k0 += 16) {
#pragma unroll
        for (int i = 0; i < 4; ++i) { const int idx = tid + i * 256, m = idx >> 4, k = idx & 15; As[k][m] = bf2f(h2[(size_t)toks[m] * DM + k0 + k]); }
#pragma unroll
        for (int i = 0; i < 8; ++i) { const int idx = tid + i * 256, k = idx >> 7, n = idx & 127; Bg[k][n] = w[(size_t)(k0 + k) * 2048 + col0 + n]; Bu[k][n] = w[(size_t)(k0 + k) * 2048 + 1024 + col0 + n]; }
        __syncthreads();
#pragma unroll
        for (int k = 0; k < 16; ++k) { float a[4], bg[8], bu[8];
#pragma unroll
            for (int i = 0; i < 4; ++i) a[i] = As[k][ty * 4 + i];
#pragma unroll
            for (int j = 0; j < 8; ++j) { bg[j] = Bg[k][tx * 8 + j]; bu[j] = Bu[k][tx * 8 + j]; }
#pragma unroll
            for (int i = 0; i < 4; ++i)
#pragma unroll
                for (int j = 0; j < 8; ++j) { ag[i][j] += a[i] * bg[j]; au[i][j] += a[i] * bu[j]; } }
        __syncthreads();
    }
    EpiGlu E{act, bgu, e, base};
#pragma unroll
    for (int i = 0; i < 4; ++i) E(row0 + ty * 4 + i, col0 + tx * 8, ag[i], au[i]);
}
__global__ __launch_bounds__(256) void naive_moe2(const u32* __restrict__ cntp, const float* __restrict__ listg, const bf16_t* __restrict__ act, const float* __restrict__ wd, const float* __restrict__ bd, bf16_t* __restrict__ ys) {
    __shared__ float As[16][68]; __shared__ float Bs[16][132];
    const int e = blockIdx.z; int base, cnt, rows; expert_ctx(cntp, e, base, cnt, rows);
    const int tid = threadIdx.x, ty = tid >> 4, tx = tid & 15, row0 = blockIdx.y * 64, col0 = blockIdx.x * 128;
    if (row0 >= rows) return;
    float acc[4][8];
#pragma unroll
    for (int i = 0; i < 4; ++i)
#pragma unroll
        for (int j = 0; j < 8; ++j) acc[i][j] = 0.f;
    const float* w = wd + (size_t)e * DFF * DM;
    for (int k0 = 0; k0 < DFF; k0 += 16) {
#pragma unroll
        for (int i = 0; i < 4; ++i) { const int idx = tid + i * 256, m = idx >> 4, k = idx & 15; As[k][m] = bf2f(act[(size_t)(base + row0 + m) * DFF + k0 + k]); }
#pragma unroll
        for (int i = 0; i < 8; ++i) { const int idx = tid + i * 256, k = idx >> 7, n = idx & 127; Bs[k][n] = w[(size_t)(k0 + k) * DM + col0 + n]; }
        __syncthreads();
#pragma unroll
        for (int k = 0; k < 16; ++k) { float a[4], b[8];
#pragma unroll
            for (int i = 0; i < 4; ++i) a[i] = As[k][ty * 4 + i];
#pragma unroll
            for (int j = 0; j < 8; ++j) b[j] = Bs[k][tx * 8 + j];
#pragma unroll
            for (int i = 0; i < 4; ++i)
#pragma unroll
                for (int j = 0; j < 8; ++j) acc[i][j] += a[i] * b[j]; }
        __syncthreads();
    }
    EpiDown E{ys, bd, listg, e, base, cnt};
#pragma unroll
    for (int i = 0; i < 4; ++i) E(row0 + ty * 4 + i, col0 + tx * 8, acc[i]);
}

__global__ __launch_bounds__(256) void naive_conv(const bf16_t* __restrict__ proj, const float* __restrict__ cw, const float* __restrict__ cb, float* __restrict__ xc) {
    const size_t idx = (size_t)blockIdx.x * 256 + threadIdx.x; const int tok = (int)(idx >> 10), ch = (int)(idx & 1023), t = tok & (SEQ - 1);
    float a = cb[ch];
#pragma unroll
    for (int k = 0; k < 4; ++k) { const int tt = t + k - 3; if (tt >= 0) a += cw[k * 1024 + ch] * bf2f(proj[(size_t)(tok + k - 3) * 1536 + 512 + ch]); }
    xc[idx] = silu(a);
}
__global__ __launch_bounds__(256) void naive_ssd(const float* __restrict__ xc, const float* __restrict__ dtr, const float* __restrict__ dt_bias, const float* __restrict__ a_log, const float* __restrict__ d_skip, float* __restrict__ y) {
    const int b = blockIdx.x >> 3, h = blockIdx.x & 7, g = h >> 2, p = threadIdx.x >> 2, nq = threadIdx.x & 3;
    const float a = -__expf(a_log[h]), dsk = d_skip[h], dtb = dt_bias[h];
    float st[32];
#pragma unroll
    for (int i = 0; i < 32; ++i) st[i] = 0.f;
    for (int t = 0; t < SEQ; ++t) {
        const size_t tok = (size_t)b * SEQ + t; const float* row = xc + tok * 1024;
        const float v = dtr[tok * 8 + h] + dtb; const float dtv = v > 20.f ? v : log1pf(__expf(v));
        const float dA = __expf(dtv * a), xv = row[h * 64 + p], xd = dtv * xv;
        const f32x4* Bp = (const f32x4*)(row + 512 + g * 128 + nq * 32); const f32x4* Cp = (const f32x4*)(row + 768 + g * 128 + nq * 32);
        float yy = 0.f;
#pragma unroll
        for (int i = 0; i < 8; ++i) { const f32x4 bv = Bp[i], cv = Cp[i];
            st[4 * i + 0] = st[4 * i + 0] * dA + xd * bv.x; yy += cv.x * st[4 * i + 0];
            st[4 * i + 1] = st[4 * i + 1] * dA + xd * bv.y; yy += cv.y * st[4 * i + 1];
            st[4 * i + 2] = st[4 * i + 2] * dA + xd * bv.z; yy += cv.z * st[4 * i + 2];
            st[4 * i + 3] = st[4 * i + 3] * dA + xd * bv.w; yy += cv.w * st[4 * i + 3]; }
        yy += __shfl_xor(yy, 1); yy += __shfl_xor(yy, 2);
        if (nq == 0) y[tok * 512 + h * 64 + p] = yy + dsk * xv;
    }
}
__global__ __launch_bounds__(256) void k_ssd_gate_norm(const float* __restrict__ y, const bf16_t* __restrict__ proj, const float* __restrict__ ng, bf16_t* __restrict__ ycat) {
    const int w = blockIdx.x * 4 + (threadIdx.x >> 6), lane = threadIdx.x & 63, tok = w >> 1, g = w & 1, c0 = g * 256 + 4 * lane;
    const f32x4 yv = *(const f32x4*)(y + (size_t)tok * 512 + c0); const u32x2 zz = *(const u32x2*)(proj + (size_t)tok * 1536 + c0);
    const float z0 = __uint_as_float(zz.x << 16), z1 = __uint_as_float(zz.x & 0xffff0000u), z2 = __uint_as_float(zz.y << 16), z3 = __uint_as_float(zz.y & 0xffff0000u);
    const float v0 = yv.x * silu(z0), v1 = yv.y * silu(z1), v2 = yv.z * silu(z2), v3 = yv.w * silu(z3);
    const float r = rsqrtf(wave_sum(v0 * v0 + v1 * v1 + v2 * v2 + v3 * v3) * (1.f / 256.f) + EPS);
    const f32x4 gg = *(const f32x4*)(ng + c0); u32x2 o; o.x = pk2(v0 * r * gg.x, v1 * r * gg.y); o.y = pk2(v2 * r * gg.z, v3 * r * gg.w);
    *(u32x2*)(ycat + (size_t)tok * DM + c0) = o;
}

__global__ __launch_bounds__(64) void naive_attn(const bf16_t* __restrict__ Q, const bf16_t* __restrict__ K, const bf16_t* __restrict__ VT, bf16_t* __restrict__ ycat) {
    const int bh = blockIdx.x >> 7, qblk = blockIdx.x & 127, b = bh >> 3, h = bh & 7, qi = qblk * 64 + threadIdx.x;
    float q[96], o[64];
#pragma unroll
    for (int dc = 0; dc < 12; ++dc) { float t[8]; load8(Q + qk_off(b, h, qi, dc), t);
#pragma unroll
        for (int j = 0; j < 8; ++j) q[dc * 8 + j] = t[j]; }
#pragma unroll
    for (int d = 0; d < 64; ++d) o[d] = 0.f;
    float m = -1e30f, l = 0.f;
    const int kmax = qblk * 64 + 63;
    for (int key = 0; key <= kmax; ++key) {
        float s = 0.f;
#pragma unroll
        for (int dc = 0; dc < 12; ++dc) { float t[8]; load8(K + qk_off(b, h, key, dc), t);
#pragma unroll
            for (int j = 0; j < 8; ++j) s += q[dc * 8 + j] * t[j]; }
        if (key <= qi) {
            const float mn = fmaxf(m, s), al = exp2f(m - mn), pp = exp2f(s - mn);
            l = l * al + pp; m = mn;
#pragma unroll
            for (int d = 0; d < 64; ++d) o[d] = o[d] * al + pp * bf2f(VT[vt_off(b, h, key, d)]);
        }
    }
    const float il = 1.f / l; const size_t tok = (size_t)b * SEQ + qi;
#pragma unroll
    for (int d = 0; d < 64; d += 8) { float t[8];
#pragma unroll
        for (int j = 0; j < 8; ++j) t[j] = o[d + j] * il;
        store8(ycat + tok * DM + 512 + h * 64 + d, t); }
}

__global__ __launch_bounds__(256) void k_router(const float* __restrict__ x1, const float* __restrict__ g, const float* __restrict__ wr, const float* __restrict__ br, bf16_t* __restrict__ h2,
                                                u32* __restrict__ cnt, int* __restrict__ list, float* __restrict__ listg, int* __restrict__ toke, int* __restrict__ tokp) {
    const int tok = blockIdx.x * 4 + (threadIdx.x >> 6), lane = threadIdx.x & 63;
    const f32x4* xr = (const f32x4*)(x1 + (size_t)tok * DM) + lane; f32x4 v[4]; float ss = 0.f;
#pragma unroll
    for (int j = 0; j < 4; ++j) { v[j] = xr[64 * j]; ss += v[j].x * v[j].x + v[j].y * v[j].y + v[j].z * v[j].z + v[j].w * v[j].w; }
    const float r = rsqrtf(wave_sum(ss) * (1.f / DM) + EPS);
    float lg[32];
#pragma unroll
    for (int e = 0; e < 32; ++e) lg[e] = 0.f;
#pragma unroll
    for (int j = 0; j < 4; ++j) { const f32x4 gg = ((const f32x4*)g)[lane + 64 * j]; const float hv[4] = {v[j].x * r * gg.x, v[j].y * r * gg.y, v[j].z * r * gg.z, v[j].w * r * gg.w};
        u32x2 w; w.x = pk2(hv[0], hv[1]); w.y = pk2(hv[2], hv[3]); *(u32x2*)(h2 + (size_t)tok * DM + 4 * (lane + 64 * j)) = w;
#pragma unroll
        for (int i = 0; i < 4; ++i) { const f32x4* wp = (const f32x4*)(wr + (size_t)(4 * (lane + 64 * j) + i) * NE);
#pragma unroll
            for (int e4 = 0; e4 < 8; ++e4) { const f32x4 ww = wp[e4]; lg[4 * e4] += hv[i] * ww.x; lg[4 * e4 + 1] += hv[i] * ww.y; lg[4 * e4 + 2] += hv[i] * ww.z; lg[4 * e4 + 3] += hv[i] * ww.w; } } }
#pragma unroll
    for (int e = 0; e < 32; ++e) lg[e] = wave_sum(lg[e]) + br[e];
    int sel[4]; float sv[4];
#pragma unroll
    for (int k = 0; k < 4; ++k) { float best = -3.0e38f; int bi = 0;
#pragma unroll
        for (int e = 0; e < 32; ++e) if (lg[e] > best) { best = lg[e]; bi = e; }
        sel[k] = bi; sv[k] = best;
#pragma unroll
        for (int e = 0; e < 32; ++e) if (e == bi) lg[e] = -3.0e38f; }
    const float e1 = __expf(sv[1] - sv[0]), e2 = __expf(sv[2] - sv[0]), e3 = __expf(sv[3] - sv[0]), inv = 1.f / (1.f + e1 + e2 + e3);
    const float gw[4] = {inv, e1 * inv, e2 * inv, e3 * inv};
    if (lane == 0) {
#pragma unroll
        for (int k = 0; k < 4; ++k) { const int e = sel[k]; const u32 p = atomicAdd(cnt + e, 1u); list[(size_t)e * NTOK + p] = tok; listg[(size_t)e * NTOK + p] = gw[k]; toke[tok * 4 + k] = e; tokp[tok * 4 + k] = (int)p; }
    }
}
__global__ __launch_bounds__(256) void k_combine(const float* __restrict__ x1, const bf16_t* __restrict__ ys, const u32* __restrict__ cnt, const int* __restrict__ toke, const int* __restrict__ tokp, const float* __restrict__ g, float* __restrict__ out) {
    const int tok = blockIdx.x * 4 + (threadIdx.x >> 6), lane = threadIdx.x & 63;
    int tiles = lane < 32 ? (int)((cnt[lane & 31] + 255) >> 8) : 0, incl = tiles;
#pragma unroll
    for (int o = 1; o < 32; o <<= 1) { const int t = __shfl_up(incl, o); if ((lane & 31) >= o) incl += t; }
    const int excl = (incl - tiles) << 8;
    f32x4 v[4];
#pragma unroll
    for (int j = 0; j < 4; ++j) v[j] = ((const f32x4*)(x1 + (size_t)tok * DM))[lane + 64 * j];
#pragma unroll
    for (int k = 0; k < 4; ++k) { const int e = toke[tok * 4 + k], p = tokp[tok * 4 + k]; const int srow = __shfl(excl, e) + p; const bf16_t* yr = ys + (size_t)srow * DM;
#pragma unroll
        for (int j = 0; j < 4; ++j) { const u32x2 w = *(const u32x2*)(yr + 4 * (lane + 64 * j));
            v[j].x += __uint_as_float(w.x << 16); v[j].y += __uint_as_float(w.x & 0xffff0000u); v[j].z += __uint_as_float(w.y << 16); v[j].w += __uint_as_float(w.y & 0xffff0000u); } }
    float ss = 0.f;
#pragma unroll
    for (int j = 0; j < 4; ++j) ss += v[j].x * v[j].x + v[j].y * v[j].y + v[j].z * v[j].z + v[j].w * v[j].w;
    const float r = rsqrtf(wave_sum(ss) * (1.f / DM) + EPS);
#pragma unroll
    for (int j = 0; j < 4; ++j) { const f32x4 gg = ((const f32x4*)g)[lane + 64 * j]; ((f32x4*)(out + (size_t)tok * DM))[lane + 64 * j] = (f32x4){v[j].x * r * gg.x, v[j].y * r * gg.y, v[j].z * r * gg.z, v[j].w * r * gg.w}; }
}

extern "C" void kernel_launch(void* const* d_in, const int* in_sizes, int n_in, void* d_out, int out_size, void* d_ws, size_t ws_size, hipStream_t stream) {
    if (n_in != 23 || in_sizes[0] != NTOK * DM || out_size != NTOK * DM || ws_size < WS_END) { fprintf(stderr, "kernel_launch: unexpected shapes (n_in %d, ws %zu)\n", n_in, ws_size); return; }
    const float* x = (const float*)d_in[0]; const int* positions = (const int*)d_in[1]; const float* norm_mix_g = (const float*)d_in[2]; const float* w_in = (const float*)d_in[3];
    const float* conv_w = (const float*)d_in[4]; const float* conv_b = (const float*)d_in[5]; const float* dt_bias = (const float*)d_in[6]; const float* a_log = (const float*)d_in[7];
    const float* d_skip = (const float*)d_in[8]; const float* ssd_norm_g = (const float*)d_in[9]; const float* q_norm_g = (const float*)d_in[10]; const float* w_uq = (const float*)d_in[11];
    const float* kv_norm_g = (const float*)d_in[12]; const float* w_ukv = (const float*)d_in[13]; const float* w_out = (const float*)d_in[14]; const float* norm_ffn_g = (const float*)d_in[15];
    const float* w_router = (const float*)d_in[16]; const float* b_router = (const float*)d_in[17]; const float* w_gate_up = (const float*)d_in[18]; const float* b_gate_up = (const float*)d_in[19];
    const float* w_down = (const float*)d_in[20]; const float* b_down = (const float*)d_in[21]; const float* norm_final_g = (const float*)d_in[22];
    char* ws = (char*)d_ws; float* out = (float*)d_out;
    u32* ctl = (u32*)(ws + WS_CTL); float* ropec = (float*)(ws + WS_ROPEC); float* ropes = (float*)(ws + WS_ROPES);
    bf16_t* H = (bf16_t*)(ws + WS_H); bf16_t* PROJ = (bf16_t*)(ws + WS_PROJ); bf16_t* CQ = (bf16_t*)(ws + WS_CQ); bf16_t* CKV = (bf16_t*)(ws + WS_CKV);
    float* DT = (float*)(ws + WS_DT); float* PARTQ = (float*)(ws + WS_PARTQ); float* PARTKV = (float*)(ws + WS_PARTKV);
    bf16_t* Qb = (bf16_t*)(ws + WS_Q); bf16_t* Kb = (bf16_t*)(ws + WS_K); bf16_t* VTb = (bf16_t*)(ws + WS_VT);
    float* Y = (float*)(ws + WS_Y); bf16_t* YCAT = (bf16_t*)(ws + WS_YCAT); float* X1 = (float*)(ws + WS_X1); bf16_t* H2 = (bf16_t*)(ws + WS_H2);
    int* TOKE = (int*)(ws + WS_TOKE); int* TOKP = (int*)(ws + WS_TOKP); int* LIST = (int*)(ws + WS_LIST); float* LISTG = (float*)(ws + WS_LISTG);
    bf16_t* ACT = (bf16_t*)(ws + WS_ACT); bf16_t* YS = (bf16_t*)(ws + WS_YS); float* XBCC = (float*)(ws + WS_XBCC);

    (void)hipMemsetAsync(ws + WS_CTL, 0, CTL_BYTES, stream);
    k_rope_table<<<NTOK * 16 / 256, 256, 0, stream>>>(positions, ropec, ropes);
    k_rmsnorm_bf16<<<NTOK / 4, 256, 0, stream>>>(x, norm_mix_g, H);
    naive_gemm<<<dim3(2048 / 128, NTOK / 64), 256, 0, stream>>>(DM, ABf16{H, DM}, BInproj{w_in}, EpiInproj{PROJ, CQ, CKV, DT, PARTQ, PARTKV, Kb, ropec, ropes});
    naive_gemm<<<dim3(768 / 128, NTOK / 64), 256, 0, stream>>>(256, ABf16{CQ, 256}, BUq{w_uq, q_norm_g}, EpiQ{Qb, PARTQ, ropec, ropes});
    naive_gemm<<<dim3(512 / 128, NTOK / 64), 256, 0, stream>>>(128, ABf16{CKV, 128}, BKn{w_ukv, kv_norm_g}, EpiKn{Kb, PARTKV});
    naive_gemm<<<dim3(NTOK / 128, 512 / 64), 256, 0, stream>>>(128, AVw{w_ukv, kv_norm_g}, BTok{CKV, 128}, EpiVt{VTb, PARTKV});
    naive_conv<<<NTOK * 1024 / 256, 256, 0, stream>>>(PROJ, conv_w, conv_b, XBCC);
    naive_ssd<<<NB * NH, 256, 0, stream>>>(XBCC, DT, dt_bias, a_log, d_skip, Y);
    k_ssd_gate_norm<<<NTOK * 2 / 4, 256, 0, stream>>>(Y, PROJ, ssd_norm_g, YCAT);
    naive_attn<<<NB * NH * 128, 64, 0, stream>>>(Qb, Kb, VTb, YCAT);
    naive_gemm<<<dim3(DM / 128, NTOK / 64), 256, 0, stream>>>(DM, ABf16{YCAT, DM}, BPlain{w_out, DM}, EpiOut{x, X1});
    k_router<<<NTOK / 4, 256, 0, stream>>>(X1, norm_ffn_g, w_router, b_router, H2, ctl + CW_CNT, LIST, LISTG, TOKE, TOKP);
    naive_moe1<<<dim3(DFF / 128, NTOK / 64, NE), 256, 0, stream>>>(ctl + CW_CNT, LIST, H2, w_gate_up, b_gate_up, ACT);
    naive_moe2<<<dim3(DM / 128, NTOK / 64, NE), 256, 0, stream>>>(ctl + CW_CNT, LISTG, ACT, w_down, b_down, YS);
    k_combine<<<NTOK / 4, 256, 0, stream>>>(X1, YS, ctl + CW_CNT, TOKE, TOKP, norm_final_g, out);
}
```

```cpp
#include <hip/hip_runtime.h>
#include <cstdio>
#include <cstdint>

typedef unsigned short bf16_t;
typedef unsigned u32;
typedef float f32x4 __attribute__((ext_vector_type(4)));
typedef unsigned u32x4 __attribute__((ext_vector_type(4)));
typedef unsigned u32x2 __attribute__((ext_vector_type(2)));
#define DI __device__ __forceinline__

constexpr int NB = 2, SEQ = 8192, DM = 1024, NTOK = NB * SEQ;
constexpr int IN_W = 1960;
constexpr int NH = 8, HP = 64, NG = 2, NST = 128, CHUNK = 128;
constexpr int QK = 96, NOPE = 64, ROPE = 32, VD = 64;
constexpr int NE = 32, TOPK = 4, DFF = 1024;
constexpr float EPS = 1e-6f;
constexpr float QSCALE = 0.14724444602590306f;
constexpr int SLOT_ROWS = NTOK * TOPK + NE * 256;

constexpr size_t MiB = 1u << 20;
constexpr size_t WS_CTL = 0, CTL_BYTES = 1 * MiB;
constexpr size_t WS_ROPEC = 1 * MiB, WS_ROPES = 2 * MiB;
constexpr size_t WS_H = 208 * MiB;
constexpr size_t WS_PROJ = 240 * MiB;
constexpr size_t WS_CQ = 288 * MiB;
constexpr size_t WS_CKV = 296 * MiB;
constexpr size_t WS_DT = 300 * MiB;
constexpr size_t WS_PARTQ = 301 * MiB;
constexpr size_t WS_PARTKV = 303 * MiB;
constexpr size_t WS_Q = 304 * MiB;
constexpr size_t WS_K = 328 * MiB;
constexpr size_t WS_VT = 352 * MiB;
constexpr size_t WS_Y = 368 * MiB;
constexpr size_t WS_STATES = 400 * MiB;
constexpr size_t WS_CD = 432 * MiB;
constexpr size_t WS_YCAT = 434 * MiB;
constexpr size_t WS_X1 = 466 * MiB;
constexpr size_t WS_H2 = 530 * MiB;
constexpr size_t WS_TOKE = 562 * MiB;
constexpr size_t WS_TOKP = WS_TOKE + 256 * 1024;
constexpr size_t WS_LIST = 563 * MiB;
constexpr size_t WS_LISTG = 565 * MiB;
constexpr size_t WS_ACT = 568 * MiB;
constexpr size_t WS_YS = 712 * MiB;
constexpr size_t WS_XBCC = 712 * MiB;
constexpr size_t WS_END = 856 * MiB;
constexpr int CW_CNT = 64;

DI float bf2f(bf16_t v) { return __uint_as_float((u32)v << 16); }
DI u32 f2bf(float f) { u32 u = __float_as_uint(f); return (u + 0x7fffu + ((u >> 16) & 1u)) >> 16; }
DI u32 pk2(float lo, float hi) { return f2bf(lo) | (f2bf(hi) << 16); }
DI void store8(bf16_t* p, const float (&v)[8]) { u32x4 w; w.x = pk2(v[0], v[1]); w.y = pk2(v[2], v[3]); w.z = pk2(v[4], v[5]); w.w = pk2(v[6], v[7]); *(u32x4*)p = w; }
DI void load8(const bf16_t* p, float (&v)[8]) { const u32x4 w = *(const u32x4*)p;
    v[0] = __uint_as_float(w.x << 16); v[1] = __uint_as_float(w.x & 0xffff0000u); v[2] = __uint_as_float(w.y << 16); v[3] = __uint_as_float(w.y & 0xffff0000u);
    v[4] = __uint_as_float(w.z << 16); v[5] = __uint_as_float(w.z & 0xffff0000u); v[6] = __uint_as_float(w.w << 16); v[7] = __uint_as_float(w.w & 0xffff0000u); }
DI float wave_sum(float v) {
#pragma unroll
    for (int o = 1; o < 64; o <<= 1) v += __shfl_xor(v, o);
    return v;
}
DI float silu(float v) { return v / (1.f + __expf(-v)); }
DI size_t qk_off(int b, int h, int s, int dc) { return ((((size_t)(b * NH + h) * 128 + (s >> 6)) * 12 + dc) * 64 + (s & 63)) * 8; }
DI size_t vt_off(int b, int h, int s, int d) {
    const int sl = s & 63, g16 = sl >> 4, w = sl & 15, a = (w >> 3) & 1, bb = (w >> 2) & 1, c = w & 3;
    return ((((size_t)(b * NH + h) * 128 + (s >> 6)) * 8 + (2 * g16 + bb)) * 64 + d) * 8 + 4 * a + c;
}
__host__ __device__ inline int inproj_src_col(int c) {
    if (c < 1536) return c;
    if (c < 1792) return 1544 + (c - 1536);
    if (c < 1920) return 1800 + (c - 1792);
    if (c < 1952) { const int i = c - 1920; return 1928 + (i >> 1) + ((i & 1) ? 16 : 0); }
    if (c < 1960) return 1536 + (c - 1952);
    return -1;
}
__host__ __device__ inline int q_src_col(int c) { const int h = c / 96, r = c - h * 96; if (r < 64) return h * 96 + r; const int i = r - 64; return h * 96 + 64 + (i >> 1) + ((i & 1) ? 16 : 0); }

__device__ const double INVF2PI[16] = {0.15915494309189535, 0.08949940160889101, 0.050329212104487035, 0.0283021958306234, 0.015915494309189534, 0.0089499401608891, 0.005032921210448704, 0.00283021958306234,
                                      0.0015915494309189536, 0.0008949940160889102, 0.0005032921210448703, 0.00028302195830623395, 0.00015915494309189535, 8.9499401608891e-05, 5.0329212104487035e-05, 2.83021958306234e-05};

__global__ __launch_bounds__(256) void k_rope_table(const int* __restrict__ pos, float* __restrict__ rc, float* __restrict__ rs) {
    const int idx = blockIdx.x * 256 + threadIdx.x; if (idx >= NTOK * 16) return;
    const int tok = idx >> 4, i = idx & 15;
    double t = (double)pos[tok] * INVF2PI[i]; t -= floor(t);
    const float fr = (float)t;
    rc[idx] = __builtin_amdgcn_cosf(fr); rs[idx] = __builtin_amdgcn_sinf(fr);
}
__global__ __launch_bounds__(256) void k_rmsnorm_bf16(const float* __restrict__ x, const float* __restrict__ g, bf16_t* __restrict__ out) {
    const int row = blockIdx.x * 4 + (threadIdx.x >> 6), lane = threadIdx.x & 63;
    const f32x4* xr = (const f32x4*)(x + (size_t)row * DM) + lane; f32x4 v[4]; float ss = 0.f;
#pragma unroll
    for (int j = 0; j < 4; ++j) { v[j] = xr[64 * j]; ss += v[j].x * v[j].x + v[j].y * v[j].y + v[j].z * v[j].z + v[j].w * v[j].w; }
    const float r = rsqrtf(wave_sum(ss) * (1.f / DM) + EPS);
#pragma unroll
    for (int j = 0; j < 4; ++j) { const f32x4 gg = ((const f32x4*)g)[lane + 64 * j]; u32x2 w; w.x = pk2(v[j].x * r * gg.x, v[j].y * r * gg.y); w.y = pk2(v[j].z * r * gg.z, v[j].w * r * gg.w);
        *(u32x2*)(out + (size_t)row * DM + 4 * (lane + 64 * j)) = w; }
}

struct EpiInproj {
    bf16_t* proj; bf16_t* cq; bf16_t* ckv; float* dt; bf16_t* kbuf; const float* ropec; const float* ropes;
    DI float rowctx(int) const { return 1.f; }
    DI void operator()(int row, int col0, const float (&v)[8], float) const {
        if (col0 < 1536) { store8(proj + (size_t)row * 1536 + col0, v); }
        else if (col0 < 1792) { store8(cq + (size_t)row * 256 + (col0 - 1536), v); }
        else if (col0 < 1920) { store8(ckv + (size_t)row * 128 + (col0 - 1792), v); }
        else if (col0 < 1952) { const int i0 = (col0 - 1920) >> 1; float o[8];
#pragma unroll
            for (int m = 0; m < 4; ++m) { const float c = ropec[(size_t)row * 16 + i0 + m], s = ropes[(size_t)row * 16 + i0 + m]; o[2 * m] = v[2 * m] * c - v[2 * m + 1] * s; o[2 * m + 1] = v[2 * m + 1] * c + v[2 * m] * s; }
            const int b = row >> 13, s_ = row & (SEQ - 1), dc = 8 + ((col0 - 1920) >> 3);
#pragma unroll
            for (int h = 0; h < NH; ++h) store8(kbuf + qk_off(b, h, s_, dc), o); }
        else if (col0 == 1952) { *(f32x4*)(dt + (size_t)row * 8) = (f32x4){v[0], v[1], v[2], v[3]}; *(f32x4*)(dt + (size_t)row * 8 + 4) = (f32x4){v[4], v[5], v[6], v[7]}; }
    }
};
DI float part_sum(const float* p, int n4) { float s = 0.f; for (int i = 0; i < n4; ++i) { const f32x4 t = ((const f32x4*)p)[i]; s += (t.x + t.y) + (t.z + t.w); } return s; }
struct EpiQ {
    bf16_t* q; const float* partq; const float* ropec; const float* ropes;
    DI float rowctx(int row) const { return partq[row] * QSCALE; }
    DI void operator()(int row, int col0, const float (&v)[8], float rs) const {
        const int h = col0 / 96, c = col0 - h * 96; float o[8];
        if (c < 64) {
#pragma unroll
            for (int j = 0; j < 8; ++j) o[j] = v[j] * rs;
        } else { const int i0 = (c - 64) >> 1;
#pragma unroll
            for (int m = 0; m < 4; ++m) { const float cc = ropec[(size_t)row * 16 + i0 + m], ss = ropes[(size_t)row * 16 + i0 + m]; const float a = v[2 * m] * rs, b = v[2 * m + 1] * rs; o[2 * m] = a * cc - b * ss; o[2 * m + 1] = b * cc + a * ss; } }
        store8(q + qk_off(row >> 13, h, row & (SEQ - 1), c >> 3), o);
    }
};
struct EpiKn {
    bf16_t* k; const float* partkv;
    DI float rowctx(int row) const { return partkv[row]; }
    DI void operator()(int row, int col0, const float (&v)[8], float rs) const {
        const int h = col0 >> 6, c = col0 & 63; float o[8];
#pragma unroll
        for (int j = 0; j < 8; ++j) o[j] = v[j] * rs;
        store8(k + qk_off(row >> 13, h, row & (SEQ - 1), c >> 3), o);
    }
};
struct EpiVt {
    bf16_t* vt; const float* partkv;
    DI float rowctx(int) const { return 1.f; }
    DI void operator()(int row, int tok0, const float (&v)[8], float) const {
        const int h = row >> 6, d = row & 63; float o[8];
#pragma unroll
        for (int j = 0; j < 8; ++j) o[j] = v[j] * partkv[tok0 + j];
        const size_t o0 = vt_off(tok0 >> 13, h, tok0 & (SEQ - 1), d), o1 = vt_off(tok0 >> 13, h, (tok0 & (SEQ - 1)) + 4, d);
        u32x2 w0, w1; w0.x = pk2(o[0], o[1]); w0.y = pk2(o[2], o[3]); w1.x = pk2(o[4], o[5]); w1.y = pk2(o[6], o[7]);
        *(u32x2*)(vt + o0) = w0; *(u32x2*)(vt + o1) = w1;
    }
};
struct EpiOut {
    const float* x; float* x1;
    DI float rowctx(int) const { return 1.f; }
    DI void operator()(int row, int col0, const float (&v)[8], float) const {
        const f32x4 a = *(const f32x4*)(x + (size_t)row * DM + col0), b = *(const f32x4*)(x + (size_t)row * DM + col0 + 4);
        *(f32x4*)(x1 + (size_t)row * DM + col0) = (f32x4){a.x + v[0], a.y + v[1], a.z + v[2], a.w + v[3]};
        *(f32x4*)(x1 + (size_t)row * DM + col0 + 4) = (f32x4){b.x + v[4], b.y + v[5], b.z + v[6], b.w + v[7]};
    }
};
struct EpiGlu {
    bf16_t* act; const float* bgu; int e, base;
    DI void operator()(int r, int f0, const float (&g)[8], const float (&u)[8]) const {
        float o[8];
#pragma unroll
        for (int j = 0; j < 8; ++j) { float gg = g[j] + bgu[(size_t)e * 2048 + f0 + j], uu = u[j] + bgu[(size_t)e * 2048 + 1024 + f0 + j];
            gg = fminf(gg, 7.f); uu = fminf(fmaxf(uu, -7.f), 7.f); const float glu = gg / (1.f + __expf(-1.702f * gg)); o[j] = (uu + 1.f) * glu; }
        store8(act + (size_t)(base + r) * DFF + f0, o);
    }
};
struct EpiDown {
    bf16_t* ys; const float* bd; const float* listg; int e, base, cnt;
    DI void operator()(int r, int c0, const float (&v)[8]) const {
        const float gw = r < cnt ? listg[(size_t)e * NTOK + r] : 0.f; float o[8];
#pragma unroll
        for (int j = 0; j < 8; ++j) o[j] = (v[j] + bd[(size_t)e * DM + c0 + j]) * gw;
        store8(ys + (size_t)(base + r) * DM + c0, o);
    }
};

template <class AF, class BF, class EF>
__global__ __launch_bounds__(256) void naive_gemm(int K, AF af, BF bf, EF ef) {
    __shared__ float As[16][68]; __shared__ float Bs[16][132];
    const int tid = threadIdx.x, ty = tid >> 4, tx = tid & 15, row0 = blockIdx.y * 64, col0 = blockIdx.x * 128;
    float acc[4][8];
#pragma unroll
    for (int i = 0; i < 4; ++i)
#pragma unroll
        for (int j = 0; j < 8; ++j) acc[i][j] = 0.f;
    for (int k0 = 0; k0 < K; k0 += 16) {
#pragma unroll
        for (int i = 0; i < 4; ++i) { const int idx = tid + i * 256, m = idx >> 4, k = idx & 15; As[k][m] = af(row0 + m, k0 + k); }
#pragma unroll
        for (int i = 0; i < 8; ++i) { const int idx = tid + i * 256, k = idx >> 7, n = idx & 127; Bs[k][n] = bf(k0 + k, col0 + n); }
        __syncthreads();
#pragma unroll
        for (int k = 0; k < 16; ++k) { float a[4], b[8];
#pragma unroll
            for (int i = 0; i < 4; ++i) a[i] = As[k][ty * 4 + i];
#pragma unroll
            for (int j = 0; j < 8; ++j) b[j] = Bs[k][tx * 8 + j];
#pragma unroll
            for (int i = 0; i < 4; ++i)
#pragma unroll
                for (int j = 0; j < 8; ++j) acc[i][j] += a[i] * b[j]; }
        __syncthreads();
    }
#pragma unroll
    for (int i = 0; i < 4; ++i) { const int row = row0 + ty * 4 + i; ef(row, col0 + tx * 8, acc[i], ef.rowctx(row)); }
}
struct ABf16 { const bf16_t* p; int ld; int pad; DI float operator()(int m, int k) const { return bf2f(p[(size_t)m * ld + k]); } };
struct BInproj { const float* w; DI float operator()(int k, int n) const { const int s = inproj_src_col(n); return s >= 0 ? w[(size_t)k * IN_W + s] : 0.f; } };
struct BUq { const float* w; const float* g; DI float operator()(int k, int n) const { return g[k] * w[(size_t)k * 768 + q_src_col(n)]; } };
struct BKn { const float* w; const float* g; DI float operator()(int k, int n) const { return g[k] * w[(size_t)k * 1024 + (n >> 6) * 128 + (n & 63)]; } };
struct AVw { const float* w; const float* g; DI float operator()(int m, int k) const { return g[k] * w[(size_t)k * 1024 + (m >> 6) * 128 + 64 + (m & 63)]; } };
struct BTok { const bf16_t* p; int ld; int pad; DI float operator()(int k, int n) const { return bf2f(p[(size_t)n * ld + k]); } };
struct BPlain { const float* w; int ld; int pad; DI float operator()(int k, int n) const { return w[(size_t)k * ld + n]; } };

DI void expert_ctx(const u32* cnt, int e, int& base, int& c, int& rows) { int b = 0; for (int i = 0; i < e; ++i) b += ((cnt[i] + 255) >> 8) << 8; base = b; c = (int)cnt[e]; rows = ((c + 255) >> 8) << 8; }
__global__ __launch_bounds__(256) void naive_moe1(const u32* __restrict__ cntp, const int* __restrict__ list, const bf16_t* __restrict__ h2, const float* __restrict__ wgu, const float* __restrict__ bgu, bf16_t* __restrict__ act) {
    __shared__ float As[16][68]; __shared__ float Bg[16][132]; __shared__ float Bu[16][132]; __shared__ int toks[64];
    const int e = blockIdx.z; int base, cnt, rows; expert_ctx(cntp, e, base, cnt, rows);
    const int tid = threadIdx.x, ty = tid >> 4, tx = tid & 15, row0 = blockIdx.y * 64, col0 = blockIdx.x * 128;
    if (row0 >= rows) return;
    if (tid < 64) { const int r = row0 + tid; toks[tid] = list[(size_t)e * NTOK + (r < cnt ? r : 0)]; }
    __syncthreads();
    float ag[4][8], au[4][8];
#pragma unroll
    for (int i = 0; i < 4; ++i)
#pragma unroll
        for (int j = 0; j < 8; ++j) { ag[i][j] = 0.f; au[i][j] = 0.f; }
    const float* w = wgu + (size_t)e * DM * 2048;
    for (int k0 = 0; k0 < DM; k0 += 16) {
#pragma unroll
        for (int i = 0; i < 4; ++i) { const int idx = tid + i * 256, m = idx >> 4, k = idx & 15; As[k][m] = bf2f(h2[(size_t)toks[m] * DM + k0 + k]); }
#pragma unroll
        for (int i = 0; i < 8; ++i) { const int idx = tid + i * 256, k = idx >> 7, n = idx & 127; Bg[k][n] = w[(size_t)(k0 + k) * 2048 + col0 + n]; Bu[k][n] = w[(size_t)(k0 + k) * 2048 + 1024 + col0 + n]; }
        __syncthreads();
#pragma unroll
        for (int k = 0; k < 16; ++k) { float a[4], bg[8], bu[8];
#pragma unroll
            for (int i = 0; i < 4; ++i) a[i] = As[k][ty * 4 + i];
#pragma unroll
            for (int j = 0; j < 8; ++j) { bg[j] = Bg[k][tx * 8 + j]; bu[j] = Bu[k][tx * 8 + j]; }
#pragma unroll
            for (int i = 0; i < 4; ++i)
#pragma unroll
                for (int j = 0; j < 8; ++j) { ag[i][j] += a[i] * bg[j]; au[i][j] += a[i] * bu[j]; } }
        __syncthreads();
    }
    EpiGlu E{act, bgu, e, base};
#pragma unroll
    for (int i = 0; i < 4; ++i) E(row0 + ty * 4 + i, col0 + tx * 8, ag[i], au[i]);
}
__global__ __launch_bounds__(256) void naive_moe2(const u32* __restrict__ cntp, const float* __restrict__ listg, const bf16_t* __restrict__ act, const float* __restrict__ wd, const float* __restrict__ bd, bf16_t* __restrict__ ys) {
    __shared__ float As[16][68]; __shared__ float Bs[16][132];
    const int e = blockIdx.z; int base, cnt, rows; expert_ctx(cntp, e, base, cnt, rows);
    const int tid = threadIdx.x, ty = tid >> 4, tx = tid & 15, row0 = blockIdx.y * 64, col0 = blockIdx.x * 128;
    if (row0 >= rows) return;
    float acc[4][8];
#pragma unroll
    for (int i = 0; i < 4; ++i)
#pragma unroll
        for (int j = 0; j < 8; ++j) acc[i][j] = 0.f;
    const float* w = wd + (size_t)e * DFF * DM;
    for (int k0 = 0; k0 < DFF; k0 += 16) {
#pragma unroll
        for (int i = 0; i < 4; ++i) { const int idx = tid + i * 256, m = idx >> 4, k = idx & 15; As[k][m] = bf2f(act[(size_t)(base + row0 + m) * DFF + k0 + k]); }
#pragma unroll
        for (int i = 0; i < 8; ++i) { const int idx = tid + i * 256, k = idx >> 7, n = idx & 127; Bs[k][n] = w[(size_t)(k0 + k) * DM + col0 + n]; }
        __syncthreads();
#pragma unroll
        for (int k = 0; k < 16; ++k) { float a[4], b[8];
#pragma unroll
            for (int i = 0; i < 4; ++i) a[i] = As[k][ty * 4 + i];
#pragma unroll
            for (int j = 0; j < 8; ++j) b[j] = Bs[k][tx * 8 + j];
#pragma unroll
            for (int i = 0; i < 4; ++i)
#pragma unroll
                for (int j = 0; j < 8; ++j) acc[i][j] += a[i] * b[j]; }
        __syncthreads();
    }
    EpiDown E{ys, bd, listg, e, base, cnt};
#pragma unroll
    for (int i = 0; i < 4; ++i) E(row0 + ty * 4 + i, col0 + tx * 8, acc[i]);
}

__global__ __launch_bounds__(256) void naive_conv(const bf16_t* __restrict__ proj, const float* __restrict__ cw, const float* __restrict__ cb, float* __restrict__ xc) {
    const size_t idx = (size_t)blockIdx.x * 256 + threadIdx.x; const int tok = (int)(idx >> 10), ch = (int)(idx & 1023), t = tok & (SEQ - 1);
    float a = cb[ch];
#pragma unroll
    for (int k = 0; k < 4; ++k) { const int tt = t + k - 3; if (tt >= 0) a += cw[k * 1024 + ch] * bf2f(proj[(size_t)(tok + k - 3) * 1536 + 512 + ch]); }
    xc[idx] = silu(a);
}
__global__ __launch_bounds__(256) void naive_ssd(const float* __restrict__ xc, const float* __restrict__ dtr, const float* __restrict__ dt_bias, const float* __restrict__ a_log, const float* __restrict__ d_skip, float* __restrict__ y) {
    const int b = blockIdx.x >> 3, h = blockIdx.x & 7, g = h >> 2, p = threadIdx.x >> 2, nq = threadIdx.x & 3;
    const float a = -__expf(a_log[h]), dsk = d_skip[h], dtb = dt_bias[h];
    float st[32];
#pragma unroll
    for (int i = 0; i < 32; ++i) st[i] = 0.f;
    for (int t = 0; t < SEQ; ++t) {
        const size_t tok = (size_t)b * SEQ + t; const float* row = xc + tok * 1024;
        const float v = dtr[tok * 8 + h] + dtb; const float dtv = v > 20.f ? v : log1pf(__expf(v));
        const float dA = __expf(dtv * a), xv = row[h * 64 + p], xd = dtv * xv;
        const f32x4* Bp = (const f32x4*)(row + 512 + g * 128 + nq * 32); const f32x4* Cp = (const f32x4*)(row + 768 + g * 128 + nq * 32);
        float yy = 0.f;
#pragma unroll
        for (int i = 0; i < 8; ++i) { const f32x4 bv = Bp[i], cv = Cp[i];
            st[4 * i + 0] = st[4 * i + 0] * dA + xd * bv.x; yy += cv.x * st[4 * i + 0];
            st[4 * i + 1] = st[4 * i + 1] * dA + xd * bv.y; yy += cv.y * st[4 * i + 1];
            st[4 * i + 2] = st[4 * i + 2] * dA + xd * bv.z; yy += cv.z * st[4 * i + 2];
            st[4 * i + 3] = st[4 * i + 3] * dA + xd * bv.w; yy += cv.w * st[4 * i + 3]; }
        yy += __shfl_xor(yy, 1); yy += __shfl_xor(yy, 2);
        if (nq == 0) y[tok * 512 + h * 64 + p] = yy + dsk * xv;
    }
}
__global__ __launch_bounds__(256) void k_ssd_gate_norm(const float* __restrict__ y, const bf16_t* __restrict__ proj, const float* __restrict__ ng, bf16_t* __restrict__ ycat) {
    const int w = blockIdx.x * 4 + (threadIdx.x >> 6), lane = threadIdx.x & 63, tok = w >> 1, g = w & 1, c0 = g * 256 + 4 * lane;
    const f32x4 yv = *(const f32x4*)(y + (size_t)tok * 512 + c0); const u32x2 zz = *(const u32x2*)(proj + (size_t)tok * 1536 + c0);
    const float z0 = __uint_as_float(zz.x << 16), z1 = __uint_as_float(zz.x & 0xffff0000u), z2 = __uint_as_float(zz.y << 16), z3 = __uint_as_float(zz.y & 0xffff0000u);
    const float v0 = yv.x * silu(z0), v1 = yv.y * silu(z1), v2 = yv.z * silu(z2), v3 = yv.w * silu(z3);
    const float r = rsqrtf(wave_sum(v0 * v0 + v1 * v1 + v2 * v2 + v3 * v3) * (1.f / 256.f) + EPS);
    const f32x4 gg = *(const f32x4*)(ng + c0); u32x2 o; o.x = pk2(v0 * r * gg.x, v1 * r * gg.y); o.y = pk2(v2 * r * gg.z, v3 * r * gg.w);
    *(u32x2*)(ycat + (size_t)tok * DM + c0) = o;
}

__global__ __launch_bounds__(64) void naive_attn(const bf16_t* __restrict__ Q, const bf16_t* __restrict__ K, const bf16_t* __restrict__ VT, bf16_t* __restrict__ ycat) {
    const int bh = blockIdx.x >> 7, qblk = blockIdx.x & 127, b = bh >> 3, h = bh & 7, qi = qblk * 64 + threadIdx.x;
    float q[96], o[64];
#pragma unroll
    for (int dc = 0; dc < 12; ++dc) { float t[8]; load8(Q + qk_off(b, h, qi, dc), t);
#pragma unroll
        for (int j = 0; j < 8; ++j) q[dc * 8 + j] = t[j]; }
#pragma unroll
    for (int d = 0; d < 64; ++d) o[d] = 0.f;
    float m = -1e30f, l = 0.f;
    const int kmax = qblk * 64 + 63;
    for (int key = 0; key <= kmax; ++key) {
        float s = 0.f;
#pragma unroll
        for (int dc = 0; dc < 12; ++dc) { float t[8]; load8(K + qk_off(b, h, key, dc), t);
#pragma unroll
            for (int j = 0; j < 8; ++j) s += q[dc * 8 + j] * t[j]; }
        if (key <= qi) {
            const float mn = fmaxf(m, s), al = exp2f(m - mn), pp = exp2f(s - mn);
            l = l * al + pp; m = mn;
#pragma unroll
            for (int d = 0; d < 64; ++d) o[d] = o[d] * al + pp * bf2f(VT[vt_off(b, h, key, d)]);
        }
    }
    const float il = 1.f / l; const size_t tok = (size_t)b * SEQ + qi;
#pragma unroll
    for (int d = 0; d < 64; d += 8) { float t[8];
#pragma unroll
        for (int j = 0; j < 8; ++j) t[j] = o[d + j] * il;
        store8(ycat + tok * DM + 512 + h * 64 + d, t); }
}

__global__ __launch_bounds__(256) void k_router(const float* __restrict__ x1, const float* __restrict__ g, const float* __restrict__ wr, const float* __restrict__ br, bf16_t* __restrict__ h2,
                                                u32* __restrict__ cnt, int* __restrict__ list, float* __restrict__ listg, int* __restrict__ toke, int* __restrict__ tokp) {
    const int tok = blockIdx.x * 4 + (threadIdx.x >> 6), lane = threadIdx.x & 63;
    const f32x4* xr = (const f32x4*)(x1 + (size_t)tok * DM) + lane; f32x4 v[4]; float ss = 0.f;
#pragma unroll
    for (int j = 0; j < 4; ++j) { v[j] = xr[64 * j]; ss += v[j].x * v[j].x + v[j].y * v[j].y + v[j].z * v[j].z + v[j].w * v[j].w; }
    const float r = rsqrtf(wave_sum(ss) * (1.f / DM) + EPS);
    float lg[32];
#pragma unroll
    for (int e = 0; e < 32; ++e) lg[e] = 0.f;
#pragma unroll
    for (int j = 0; j < 4; ++j) { const f32x4 gg = ((const f32x4*)g)[lane + 64 * j]; const float hv[4] = {v[j].x * r * gg.x, v[j].y * r * gg.y, v[j].z * r * gg.z, v[j].w * r * gg.w};
        u32x2 w; w.x = pk2(hv[0], hv[1]); w.y = pk2(hv[2], hv[3]); *(u32x2*)(h2 + (size_t)tok * DM + 4 * (lane + 64 * j)) = w;
#pragma unroll
        for (int i = 0; i < 4; ++i) { const f32x4* wp = (const f32x4*)(wr + (size_t)(4 * (lane + 64 * j) + i) * NE);
#pragma unroll
            for (int e4 = 0; e4 < 8; ++e4) { const f32x4 ww = wp[e4]; lg[4 * e4] += hv[i] * ww.x; lg[4 * e4 + 1] += hv[i] * ww.y; lg[4 * e4 + 2] += hv[i] * ww.z; lg[4 * e4 + 3] += hv[i] * ww.w; } } }
#pragma unroll
    for (int e = 0; e < 32; ++e) lg[e] = wave_sum(lg[e]) + br[e];
    int sel[4]; float sv[4];
#pragma unroll
    for (int k = 0; k < 4; ++k) { float best = -3.0e38f; int bi = 0;
#pragma unroll
        for (int e = 0; e < 32; ++e) if (lg[e] > best) { best = lg[e]; bi = e; }
        sel[k] = bi; sv[k] = best;
#pragma unroll
        for (int e = 0; e < 32; ++e) if (e == bi) lg[e] = -3.0e38f; }
    const float e1 = __expf(sv[1] - sv[0]), e2 = __expf(sv[2] - sv[0]), e3 = __expf(sv[3] - sv[0]), inv = 1.f / (1.f + e1 + e2 + e3);
    const float gw[4] = {inv, e1 * inv, e2 * inv, e3 * inv};
    if (lane == 0) {
#pragma unroll
        for (int k = 0; k < 4; ++k) { const int e = sel[k]; const u32 p = atomicAdd(cnt + e, 1u); list[(size_t)e * NTOK + p] = tok; listg[(size_t)e * NTOK + p] = gw[k]; toke[tok * 4 + k] = e; tokp[tok * 4 + k] = (int)p; }
    }
}
__global__ __launch_bounds__(256) void k_combine(const float* __restrict__ x1, const bf16_t* __restrict__ ys, const u32* __restrict__ cnt, const int* __restrict__ toke, const int* __restrict__ tokp, const float* __restrict__ g, float* __restrict__ out) {
    const int tok = blockIdx.x * 4 + (threadIdx.x >> 6), lane = threadIdx.x & 63;
    int tiles = lane < 32 ? (int)((cnt[lane & 31] + 255) >> 8) : 0, incl = tiles;
#pragma unroll
    for (int o = 1; o < 32; o <<= 1) { const int t = __shfl_up(incl, o); if ((lane & 31) >= o) incl += t; }
    const int excl = (incl - tiles) << 8;
    f32x4 v[4];
#pragma unroll
    for (int j = 0; j < 4; ++j) v[j] = ((const f32x4*)(x1 + (size_t)tok * DM))[lane + 64 * j];
#pragma unroll
    for (int k = 0; k < 4; ++k) { const int e = toke[tok * 4 + k], p = tokp[tok * 4 + k]; const int srow = __shfl(excl, e) + p; const bf16_t* yr = ys + (size_t)srow * DM;
#pragma unroll
        for (int j = 0; j < 4; ++j) { const u32x2 w = *(const u32x2*)(yr + 4 * (lane + 64 * j));
            v[j].x += __uint_as_float(w.x << 16); v[j].y += __uint_as_float(w.x & 0xffff0000u); v[j].z += __uint_as_float(w.y << 16); v[j].w += __uint_as_float(w.y & 0xffff0000u); } }
    float ss = 0.f;
#pragma unroll
    for (int j = 0; j < 4; ++j) ss += v[j].x * v[j].x + v[j].y * v[j].y + v[j].z * v[j].z + v[j].w * v[j].w;
    const float r = rsqrtf(wave_sum(ss) * (1.f / DM) + EPS);
#pragma unroll
    for (int j = 0; j < 4; ++j) { const f32x4 gg = ((const f32x4*)g)[lane + 64 * j]; ((f32x4*)(out + (size_t)tok * DM))[lane + 64 * j] = (f32x4){v[j].x * r * gg.x, v[j].y * r * gg.y, v[j].z * r * gg.z, v[j].w * r * gg.w}; }
}


#define LAS __attribute__((address_space(3)))
#define GAS __attribute__((address_space(1)))
typedef short bf16x8 __attribute__((ext_vector_type(8)));
typedef GAS unsigned gu32;
#define RLX_AGENT __ATOMIC_RELAXED, __HIP_MEMORY_SCOPE_AGENT
namespace pg8 {
constexpr int BM = 256, BK = 64, HALF = 128, HTB = HALF * BK * 2  , STAGE_BYTES = 8 * HTB;
__host__ __device__ __forceinline__ int lds_byte(int r, int c) { const int st = (r >> 4) * 2 + (c >> 5), rr = r & 15, cc = c & 31, ob = rr * 64 + cc * 2; return st * 1024 + (ob ^ (((ob >> 9) & 1) << 5)); }
__host__ __device__ __forceinline__ void stage_rc(int b, int& R, int& C) { const int st = b / 1024, sb = b % 1024, swz = sb ^ (((sb >> 9) & 1) << 5); R = (st >> 1) * 16 + swz / 64; C = (st & 1) * 32 + (swz % 64) / 2; }
__host__ __device__ __forceinline__ int perm32(int rho) { const int n = rho >> 4, i = rho & 15; return 8 * (i >> 2) + 4 * n + (i & 3); }

struct Unit { int pm, pn; const char* A; const char* B; int e, base, cnt, pad; };

template <class Epi, class Sched>
__device__ __forceinline__ void gemm_phase(LAS unsigned char* lds, const int K_, const Sched& S, const Epi& E) {
    int K = K_; asm volatile("" : "+s"(K));
    const int tid = threadIdx.x, wid = __builtin_amdgcn_readfirstlane(tid >> 6), lane = tid & 63, wr = wid >> 2, wc = wid & 3, fr = lane & 15, fq = lane >> 4;
    const int nt = K / BK;
    int RA[2], CA[2]; unsigned voffB[2];
#pragma unroll
    for (int i = 0; i < 2; ++i) { int R, C; stage_rc(tid * 16 + i * 8192, R, C); const int Rb = (R & ~31) + perm32(R & 31); RA[i] = R; CA[i] = C; voffB[i] = (unsigned)(Rb * K + C) * 2u; }
    const size_t kstep = (size_t)(BK * 2);
    const size_t hstepB = (size_t)HALF * K * 2;
    const unsigned ldsw = (unsigned)wid * 1024u;
    const int aoff = lds_byte(wr * 64 + fr, fq * 8), boff = lds_byte(wc * 32 + fr, fq * 8);
#define PG8_SA(b, h) (((b) * 2 + (h)) * HTB)
#define PG8_SB(b, h) ((4 + (b) * 2 + (h)) * HTB)
#define PG8_STAGE(bufoff, gbase, v0, v1) do { \
        __builtin_amdgcn_global_load_lds((const unsigned*)((const char*)(gbase) + (v0)), (LAS unsigned*)(lds + (bufoff) + ldsw), 16, 0, 0); \
        __builtin_amdgcn_global_load_lds((const unsigned*)((const char*)(gbase) + (v1)), (LAS unsigned*)(lds + (bufoff) + ldsw + 8192), 16, 0, 0); } while (0)
#define PG8_STAGEB(bufoff, gbase) PG8_STAGE(bufoff, gbase, voffB[0], voffB[1])
#define PG8_LDA(dst, b, h) do { _Pragma("unroll") for (int m = 0; m < 4; ++m) _Pragma("unroll") for (int k = 0; k < 2; ++k) dst[m][k] = *(const LAS bf16x8*)(lds + PG8_SA(b, h) + aoff + m * 2048 + k * 1024); } while (0)
#define PG8_LDB(dst, b, h) do { _Pragma("unroll") for (int n = 0; n < 2; ++n) _Pragma("unroll") for (int k = 0; k < 2; ++k) dst[n][k] = *(const LAS bf16x8*)(lds + PG8_SB(b, h) + boff + n * 2048 + k * 1024); } while (0)
#define PG8_MMA(ai, bj, At, Bt) do { __builtin_amdgcn_s_setprio(1); _Pragma("unroll") for (int m = 0; m < 4; ++m) _Pragma("unroll") for (int n = 0; n < 2; ++n) _Pragma("unroll") for (int k = 0; k < 2; ++k) \
        acc[ai][bj][m][n] = __builtin_amdgcn_mfma_f32_16x16x32_bf16(Bt[n][k], At[m][k], acc[ai][bj][m][n], 0, 0, 0); __builtin_amdgcn_s_setprio(0); } while (0)
#define PG8_WAIT_V(n) asm volatile("s_waitcnt vmcnt(" #n ")" ::: "memory")
#define PG8_WAIT_L(n) asm volatile("s_waitcnt lgkmcnt(" #n ")" ::: "memory")
#define PG8_BAR __builtin_amdgcn_s_barrier()
#define PG8_SCHED __builtin_amdgcn_sched_barrier(0)
    Unit cur, nxt; int ui = 0;
    if (!S.next(0, cur)) return;
    f32x4 acc[2][2][4][2];
#pragma unroll
    for (int a = 0; a < 2; ++a)
#pragma unroll
        for (int b = 0; b < 2; ++b)
#pragma unroll
            for (int m = 0; m < 4; ++m)
#pragma unroll
                for (int n = 0; n < 2; ++n) acc[a][b][m][n] = (f32x4){0.f, 0.f, 0.f, 0.f};
    bf16x8 At[4][2], B0[2][2], B1[2][2];
    unsigned vc[2][2], vn[2][2];
#pragma unroll
    for (int h = 0; h < 2; ++h)
#pragma unroll
        for (int i = 0; i < 2; ++i) { vc[h][i] = S.arow(cur, RA[i] + h * HALF) + (unsigned)CA[i] * 2u; vn[h][i] = vc[h][i]; }
    const char* cA = cur.A; const char* cB = cur.B;
    PG8_STAGEB(PG8_SB(0, 0), cB); PG8_STAGEB(PG8_SB(0, 1), cB + hstepB); PG8_STAGE(PG8_SA(0, 0), cA, vc[0][0], vc[0][1]); PG8_STAGE(PG8_SA(0, 1), cA, vc[1][0], vc[1][1]);
    if (wr == 1) PG8_BAR;
    PG8_WAIT_V(2); PG8_BAR;
    PG8_STAGEB(PG8_SB(1, 0), cB + kstep); PG8_STAGE(PG8_SA(1, 0), cA + kstep, vc[0][0], vc[0][1]); PG8_STAGEB(PG8_SB(1, 1), cB + hstepB + kstep);
    PG8_WAIT_V(6); PG8_BAR;
#pragma unroll 1
    for (;;) {
        const bool has_next = S.next(ui + 1, nxt);
        const char* nA = has_next ? nxt.A : cA; const char* nB = has_next ? nxt.B : cB;
        if (Sched::GATHER) { if (has_next) {
#pragma unroll
            for (int h = 0; h < 2; ++h)
#pragma unroll
                for (int i = 0; i < 2; ++i) vn[h][i] = S.arow(nxt, RA[i] + h * HALF) + (unsigned)CA[i] * 2u; } }
#pragma unroll 1
        for (int t = 0; t < nt; t += 2) {
            const bool last = (t == nt - 2);
            const char* a1 = cA + (size_t)(t + 1) * kstep;
            const char* a2 = last ? nA : cA + (size_t)(t + 2) * kstep; const char* b2 = last ? nB : cB + (size_t)(t + 2) * kstep;
            const char* a3 = a2 + kstep; const char* b3 = b2 + kstep;
            unsigned v2[2][2];
#pragma unroll
            for (int h = 0; h < 2; ++h)
#pragma unroll
                for (int i = 0; i < 2; ++i) v2[h][i] = (Sched::GATHER && last) ? vn[h][i] : vc[h][i];
            PG8_LDB(B0, 0, 0); PG8_LDB(B1, 0, 1); PG8_SCHED; PG8_LDA(At, 0, 0); PG8_STAGE(PG8_SA(1, 1), a1, vc[1][0], vc[1][1]);
            PG8_WAIT_V(8); PG8_WAIT_L(0); PG8_BAR; PG8_MMA(0, 0, At, B0); PG8_MMA(0, 1, At, B1); PG8_BAR; PG8_SCHED;
            PG8_LDA(At, 0, 1); PG8_STAGEB(PG8_SB(0, 0), b2); PG8_STAGEB(PG8_SB(0, 1), b2 + hstepB); PG8_STAGE(PG8_SA(0, 0), a2, v2[0][0], v2[0][1]);
            PG8_WAIT_V(8); PG8_WAIT_L(0); PG8_BAR; PG8_MMA(1, 0, At, B0); PG8_MMA(1, 1, At, B1); PG8_BAR; PG8_SCHED;
            PG8_LDB(B0, 1, 0); PG8_LDB(B1, 1, 1); PG8_SCHED; PG8_LDA(At, 1, 0); PG8_STAGE(PG8_SA(0, 1), a2, v2[1][0], v2[1][1]);
            PG8_WAIT_V(8); PG8_WAIT_L(0); PG8_BAR; PG8_MMA(0, 0, At, B0); PG8_MMA(0, 1, At, B1); PG8_BAR; PG8_SCHED;
            PG8_LDA(At, 1, 1); PG8_STAGEB(PG8_SB(1, 0), b3); PG8_STAGEB(PG8_SB(1, 1), b3 + hstepB); PG8_STAGE(PG8_SA(1, 0), a3, v2[0][0], v2[0][1]);
            PG8_WAIT_V(8); PG8_WAIT_L(0); PG8_BAR; PG8_MMA(1, 0, At, B0); PG8_MMA(1, 1, At, B1); PG8_BAR; PG8_SCHED;
        }
        if (wr == 0) PG8_BAR;
        E(acc, cur, wr, wc, fr, fq);
        if (!has_next) break;
#pragma unroll
        for (int a = 0; a < 2; ++a)
#pragma unroll
            for (int b = 0; b < 2; ++b)
#pragma unroll
                for (int m = 0; m < 4; ++m)
#pragma unroll
                    for (int n = 0; n < 2; ++n) acc[a][b][m][n] = (f32x4){0.f, 0.f, 0.f, 0.f};
        cur = nxt; cA = nA; cB = nB; ++ui;
#pragma unroll
        for (int h = 0; h < 2; ++h)
#pragma unroll
            for (int i = 0; i < 2; ++i) vc[h][i] = vn[h][i];
        if (wr == 1) PG8_BAR;
    }
    PG8_WAIT_V(0);
    PG8_BAR;
#undef PG8_SA
#undef PG8_SB
#undef PG8_STAGE
#undef PG8_STAGEB
#undef PG8_LDA
#undef PG8_LDB
#undef PG8_MMA
#undef PG8_WAIT_V
#undef PG8_WAIT_L
#undef PG8_BAR
#undef PG8_SCHED
}

template <class EF> struct EpiRows {
    EF ef;
    __device__ __forceinline__ void operator()(const f32x4 (&acc)[2][2][4][2], const Unit& u, int wr, int wc, int fr, int fq) const {
        const int row0 = u.pm * BM + wr * 64 + fr, col0 = u.pn * BM + wc * 32 + 8 * fq;
#pragma unroll
        for (int ai = 0; ai < 2; ++ai)
#pragma unroll
            for (int m = 0; m < 4; ++m) { const int row = row0 + ai * HALF + m * 16; const float ctx = ef.rowctx(row);
#pragma unroll
                for (int bj = 0; bj < 2; ++bj) { const f32x4 a = acc[ai][bj][m][0], b = acc[ai][bj][m][1]; const float v[8] = {a[0], a[1], a[2], a[3], b[0], b[1], b[2], b[3]}; ef(row, col0 + bj * HALF, v, ctx); } }
    }
};
struct GridOrder {
    const char* A; const char* Bt; int K, nM, nN, G, vcu, pad;
    static constexpr bool GATHER = false;
    __device__ __forceinline__ bool next(int i, Unit& u) const { const int L = i * G + vcu; if (L >= nM * nN) return false; u.pm = L / nN; u.pn = L - u.pm * nN;
        u.A = A + (size_t)u.pm * BM * K * 2; u.B = Bt + (size_t)u.pn * BM * K * 2; u.e = 0; u.base = 0; u.cnt = 0; u.pad = 0; return true; }
    __device__ __forceinline__ unsigned arow(const Unit&, int R) const { return (unsigned)(R * K) * 2u; }
};
}

#define XB_TMO      128
#define XB_XCNT(j)  (256  + 64 * (j))
#define XB_XSUB(j)  (1280 + 64 * (j))
#define XB_XGEN(j)  (2304 + 64 * (j))
#define XB_TOP      3328
#define XB_TOPGEN   3392
#define XCD_BAR_WORDS 3456
#define XB_SPIN_CAP (1u << 18)
__device__ __forceinline__ unsigned xb_ld(unsigned* p)              { return __hip_atomic_load(p, __ATOMIC_RELAXED, __HIP_MEMORY_SCOPE_AGENT); }
__device__ __forceinline__ unsigned xb_add(unsigned* p, unsigned v) { return __hip_atomic_fetch_add(p, v, __ATOMIC_RELAXED, __HIP_MEMORY_SCOPE_AGENT); }
__device__ __forceinline__ unsigned xb_xcc_id() { return (unsigned)__builtin_amdgcn_s_getreg((3 << 11) | 20) & 0xFu; }
#define XB_SPIN(cond, bar) do { unsigned _sp = 0; while (cond) { __builtin_amdgcn_s_sleep(1); \
    if ((++_sp & 255u) == 0u) { if (xb_ld(&(bar)[XB_TMO])) break; if (_sp > XB_SPIN_CAP) { atomicAdd(&(bar)[XB_TMO], 1u); break; } } } } while (0)
struct XcdBarrier { unsigned* bar; unsigned x; volatile LAS unsigned* st; };
__device__ __forceinline__ XcdBarrier xcd_barrier_post(unsigned* bar, volatile LAS unsigned* st) {
    XcdBarrier b; b.bar = bar; b.x = xb_xcc_id(); b.st = st;
    if (threadIdx.x == 0) (void)xb_add(&bar[XB_XCNT(b.x)], 1u);
    return b;
}
__device__ __forceinline__ void xcd_barrier_complete(unsigned* bar, unsigned x, unsigned& nloc, unsigned& nx) {
    const unsigned G = gridDim.x * gridDim.y * gridDim.z;
    unsigned sum, cnt, mine, sp = 0u;
    for (;;) {
        sum = 0u; cnt = 0u; mine = 0u;
#pragma unroll
        for (unsigned j = 0; j < 16; ++j) { const unsigned c = xb_ld(&bar[XB_XCNT(j)]); sum += c; cnt += (c > 0u) ? 1u : 0u; mine = (j == x) ? c : mine; }
        if (sum == G) break;
        __builtin_amdgcn_s_sleep(1);
        if ((++sp & 255u) == 0u) { if (xb_ld(&bar[XB_TMO])) break; if (sp > XB_SPIN_CAP) { atomicAdd(&bar[XB_TMO], 1u); break; } }
    }
    nloc = mine > 0u ? mine : 1u; nx = cnt > 0u ? cnt : 1u;
}
__device__ __forceinline__ void xcd_barrier(const XcdBarrier& b) {
    asm volatile("s_waitcnt vmcnt(0)" ::: "memory");
    __syncthreads();
    if (threadIdx.x == 0) {
        unsigned* bar = b.bar;
        __builtin_amdgcn_s_waitcnt(0);
        unsigned nloc = b.st[0], nx = b.st[1];
        if (nloc == 0u) { xcd_barrier_complete(bar, b.x, nloc, nx); b.st[0] = nloc; b.st[1] = nx; }
        const unsigned old = xb_add(&bar[XB_XSUB(b.x)], 1u);
        const unsigned gen = old / nloc;
        if (old + 1u == (gen + 1u) * nloc) {
            __builtin_amdgcn_fence(__ATOMIC_RELEASE, "agent");
            asm volatile("s_waitcnt vmcnt(0)" ::: "memory");
            const unsigned og = xb_add(&bar[XB_TOP], 1u);
            const unsigned tg = og / nx;
            if (og + 1u == (tg + 1u) * nx) xb_add(&bar[XB_TOPGEN], 1u);
            else XB_SPIN(xb_ld(&bar[XB_TOPGEN]) == tg, bar);
            __builtin_amdgcn_fence(__ATOMIC_ACQUIRE, "agent");
            xb_add(&bar[XB_XGEN(b.x)], 1u);
            asm volatile("s_waitcnt vmcnt(0)" ::: "memory");
        } else {
            XB_SPIN(xb_ld(&bar[XB_XGEN(b.x)]) == gen, bar);
            __builtin_amdgcn_fence(__ATOMIC_ACQUIRE, "agent");
            asm volatile("s_waitcnt vmcnt(0)" ::: "memory");
        }
    }
    __syncthreads();
}

constexpr int NWAVES = 8, NTHR = 512;
constexpr int RING_BYTES = 131072, LDSCTL_OFF = RING_BYTES, MISC_OFF = LDSCTL_OFF + 320, LDS_BYTES = 147456;
constexpr int CW_BAR = 4096;
constexpr size_t WS_WIN = 4 * MiB, WS_WUQ = 8 * MiB, WS_WKN = 9 * MiB, WS_WV = 9 * MiB + 512 * 1024, WS_WOUT = 10 * MiB, WS_WGU = 16 * MiB, WS_WDN = 144 * MiB;

struct Args { const void* in[23]; float* out; unsigned char* ws; int ph_lo, ph_hi; };

template <class SrcMap>
__device__ __forceinline__ void p0_tile(const float* __restrict__ W, int ldw, int K, const float* __restrict__ gk, bf16_t* __restrict__ WT, int k0, int n0, const SrcMap& sm, int lane) {
    const int src = sm(n0 + lane);
    float v[64];
    if (src >= 0) {
#pragma unroll
        for (int i = 0; i < 64; ++i) v[i] = W[(size_t)(k0 + i) * ldw + src];
        if (gk) {
#pragma unroll
            for (int i = 0; i < 64; ++i) v[i] *= gk[k0 + i];
        }
    } else {
#pragma unroll
        for (int i = 0; i < 64; ++i) v[i] = 0.f;
    }
    bf16_t* o = WT + (size_t)(n0 + lane) * K + k0;
#pragma unroll
    for (int i = 0; i < 8; ++i) { u32x4 w; w.x = pk2(v[8 * i], v[8 * i + 1]); w.y = pk2(v[8 * i + 2], v[8 * i + 3]); w.z = pk2(v[8 * i + 4], v[8 * i + 5]); w.w = pk2(v[8 * i + 6], v[8 * i + 7]); *(u32x4*)(o + 8 * i) = w; }
}
struct MapIn { __device__ __forceinline__ int operator()(int c) const { return inproj_src_col(c); } };
struct MapQ { __device__ __forceinline__ int operator()(int c) const { return q_src_col(c); } };
struct MapKn { __device__ __forceinline__ int operator()(int c) const { return (c >> 6) * 128 + (c & 63); } };
struct MapV { __device__ __forceinline__ int operator()(int c) const { return (c >> 6) * 128 + 64 + (c & 63); } };
struct MapId { __device__ __forceinline__ int operator()(int c) const { return c; } };
struct MapGU { __device__ __forceinline__ int operator()(int c) const { const int t = c >> 8, r = c & 255; return r < 128 ? 128 * t + r : 1024 + 128 * t + (r - 128); } };

namespace pg8 {
struct EpiColsVt {
    bf16_t* vt; const float* partkv;
    __device__ __forceinline__ void operator()(const f32x4 (&acc)[2][2][4][2], const Unit& u, int wr, int wc, int fr, int fq) const {
        const int row0 = u.pm * BM + wr * 64 + fr, col0 = u.pn * BM + wc * 32 + 8 * fq;
#pragma unroll
        for (int bj = 0; bj < 2; ++bj) {
            const int tok0 = col0 + bj * HALF, b = tok0 >> 13, s = tok0 & (SEQ - 1), sl = s & 63;
            const unsigned tbase = (unsigned)(((b * NH * 128 + (s >> 6)) * 8 + 2 * (sl >> 4)) * 512 + 4 * ((sl >> 3) & 1));
            const f32x4 s0 = *(const f32x4*)(partkv + tok0), s1 = *(const f32x4*)(partkv + tok0 + 4);
#pragma unroll
            for (int ai = 0; ai < 2; ++ai)
#pragma unroll
                for (int m = 0; m < 4; ++m) { const int row = row0 + ai * HALF + m * 16, h = row >> 6, d = row & 63;
                    const f32x4 a = acc[ai][bj][m][0], bb = acc[ai][bj][m][1]; const unsigned o0 = tbase + (unsigned)h * 524288u + (unsigned)d * 8u;
                    u32x2 w0, w1; w0.x = pk2(a[0] * s0[0], a[1] * s0[1]); w0.y = pk2(a[2] * s0[2], a[3] * s0[3]); w1.x = pk2(bb[0] * s1[0], bb[1] * s1[1]); w1.y = pk2(bb[2] * s1[2], bb[3] * s1[3]);
                    *(u32x2*)(vt + o0) = w0; *(u32x2*)(vt + o0 + 512) = w1; }
            asm volatile("" ::: "memory");
        }
    }
};
struct EpiMoeGlu {
    bf16_t* act; const float* bgu;
    __device__ __forceinline__ void operator()(const f32x4 (&acc)[2][2][4][2], const Unit& u, int wr, int wc, int fr, int fq) const {
        const EpiGlu E{act, bgu, u.e, u.base}; const int r0 = u.pm * BM + wr * 64 + fr, f0 = u.pn * HALF + wc * 32 + 8 * fq;
#pragma unroll
        for (int ai = 0; ai < 2; ++ai)
#pragma unroll
            for (int m = 0; m < 4; ++m) { const f32x4 g0 = acc[ai][0][m][0], g1 = acc[ai][0][m][1], u0 = acc[ai][1][m][0], u1 = acc[ai][1][m][1];
                const float g[8] = {g0[0], g0[1], g0[2], g0[3], g1[0], g1[1], g1[2], g1[3]}, uu[8] = {u0[0], u0[1], u0[2], u0[3], u1[0], u1[1], u1[2], u1[3]};
                E(r0 + ai * HALF + m * 16, f0, g, uu); }
    }
};
struct EpiMoeDown {
    bf16_t* ys; const float* bd; const float* listg;
    __device__ __forceinline__ void operator()(const f32x4 (&acc)[2][2][4][2], const Unit& u, int wr, int wc, int fr, int fq) const {
        const EpiDown E{ys, bd, listg, u.e, u.base, u.cnt}; const int r0 = u.pm * BM + wr * 64 + fr, c0 = u.pn * BM + wc * 32 + 8 * fq;
#pragma unroll
        for (int ai = 0; ai < 2; ++ai)
#pragma unroll
            for (int m = 0; m < 4; ++m)
#pragma unroll
                for (int bj = 0; bj < 2; ++bj) { const f32x4 a = acc[ai][bj][m][0], b = acc[ai][bj][m][1]; const float v[8] = {a[0], a[1], a[2], a[3], b[0], b[1], b[2], b[3]}; E(r0 + ai * HALF + m * 16, c0 + bj * HALF, v); }
    }
};
struct EpiInprojMfma {
    EpiInproj ef; float* scaleq; float* scalekv; LAS float* P;
    __device__ __forceinline__ void operator()(const f32x4 (&acc)[2][2][4][2], const Unit& u, int wr, int wc, int fr, int fq) const {
        const int row0 = u.pm * BM + wr * 64 + fr, col0 = u.pn * BM + wc * 32 + 8 * fq;
#pragma unroll
        for (int ai = 0; ai < 2; ++ai)
#pragma unroll
            for (int m = 0; m < 4; ++m) { const int row = row0 + ai * HALF + m * 16;
#pragma unroll
                for (int bj = 0; bj < 2; ++bj) { const f32x4 a = acc[ai][bj][m][0], b = acc[ai][bj][m][1]; const float v[8] = {a[0], a[1], a[2], a[3], b[0], b[1], b[2], b[3]}; ef(row, col0 + bj * HALF, v, 1.f); } }
        if (u.pn >= 6) {
            const bool isq = (u.pn == 6);
#pragma unroll
            for (int ai = 0; ai < 2; ++ai)
#pragma unroll
                for (int m = 0; m < 4; ++m) { float s = 0.f;
#pragma unroll
                    for (int n = 0; n < 2; ++n) { const f32x4 x = acc[ai][0][m][n]; s += (x[0] * x[0] + x[1] * x[1]) + (x[2] * x[2] + x[3] * x[3]); }
                    if (isq) {
#pragma unroll
                        for (int n = 0; n < 2; ++n) { const f32x4 x = acc[ai][1][m][n]; s += (x[0] * x[0] + x[1] * x[1]) + (x[2] * x[2] + x[3] * x[3]); } }
                    s += __shfl_xor(s, 16); s += __shfl_xor(s, 32);
                    if (fq == 0) P[(ai * HALF + wr * 64 + m * 16 + fr) * 4 + wc] = s; }
            asm volatile("s_waitcnt lgkmcnt(0)" ::: "memory"); __builtin_amdgcn_s_barrier(); asm volatile("" ::: "memory");
            const int t = threadIdx.x;
            if (t < 256) { const f32x4 p = *(const LAS f32x4*)(P + t * 4); const float sum = (p[0] + p[1]) + (p[2] + p[3]);
                if (isq) scaleq[u.pm * BM + t] = rsqrtf(sum * (1.f / 256.f) + EPS); else scalekv[u.pm * BM + t] = rsqrtf(sum * (1.f / 128.f) + EPS); }
            asm volatile("s_waitcnt lgkmcnt(0)" ::: "memory"); __builtin_amdgcn_s_barrier(); asm volatile("" ::: "memory");
        }
    }
};
struct GridOrderRot {
    const char* A; const char* Bt; int K, nM, nN, G, vcu, rot;
    static constexpr bool GATHER = false;
    __device__ __forceinline__ bool next(int i, Unit& u) const { int w = vcu - rot; if (w < 0) w += G; const int L = i * G + w; if (L >= nM * nN) return false; u.pm = L / nN; u.pn = L - u.pm * nN;
        u.A = A + (size_t)u.pm * BM * K * 2; u.B = Bt + (size_t)u.pn * BM * K * 2; u.e = 0; u.base = 0; u.cnt = 0; u.pad = 0; return true; }
    __device__ __forceinline__ unsigned arow(const Unit&, int R) const { return (unsigned)(R * K) * 2u; }
};
template <bool GATH> struct MoeOrder {
    const char* A; const char* Bt; const u32* cnt; const int* list; int K, nN, nfull, G, vcu, pad;
    static constexpr bool GATHER = GATH;
    __device__ __forceinline__ bool next(int i, Unit& u) const {
        const int L = i * G + vcu, mt = L / nN; int acc = 0, e = 0, c = 0;
        for (; e < NE; ++e) { c = (int)cnt[e]; const int t = (c + 255) >> 8; if (mt < acc + t) break; acc += t; }
        if (e >= NE) return false;
        u.e = e; u.base = acc << 8; u.cnt = c; u.pm = mt - acc; u.pn = L - mt * nN; u.pad = 0;
        u.A = GATH ? A : A + (size_t)(u.base + u.pm * BM) * K * 2; u.B = Bt + ((size_t)e * nfull + (size_t)u.pn * BM) * K * 2; return true;
    }
    __device__ __forceinline__ unsigned arow(const Unit& u, int R) const {
        if (!GATH) return (unsigned)(R * K) * 2u;
        const int r = u.pm * BM + R; const int tok = list[(size_t)u.e * NTOK + (r < u.cnt ? r : 0)]; return (unsigned)tok * (unsigned)K * 2u;
    }
};
}

namespace att {
typedef float f32x16 __attribute__((ext_vector_type(16)));
typedef float f32x2_t __attribute__((ext_vector_type(2))); typedef __bf16 bf16x2_t __attribute__((ext_vector_type(2)));
__device__ __forceinline__ unsigned cvtpk(float lo, float hi) { f32x2_t v = {lo, hi}; bf16x2_t b = __builtin_convertvector(v, bf16x2_t); return __builtin_bit_cast(unsigned, b); }
__device__ __forceinline__ int crow(int r, int hi) { return (r & 3) + 8 * (r >> 2) + 4 * hi; }
constexpr int KTB = 12288, VTB = 8192, BUFB = KTB + VTB;
constexpr int LDS_NEED = 2 * BUFB;
#define ATT_MFMA(a, b, c) __builtin_amdgcn_mfma_f32_32x32x16_bf16((a), (b), (c), 0, 0, 0)

__device__ __forceinline__ void attn_unit(LAS unsigned char* lds, int b, int h, int qb, const bf16_t* __restrict__ Q, const bf16_t* __restrict__ K, const bf16_t* __restrict__ VT, bf16_t* __restrict__ ycat) {
    const int tid = threadIdx.x, lane = tid & 63, r32 = lane & 31, hi = lane >> 5, w = __builtin_amdgcn_readfirstlane(tid >> 6);
    const int q0 = qb * 256 + w * 32;
    bf16x8 qf[6];
#pragma unroll
    for (int s = 0; s < 6; ++s) qf[s] = *(const bf16x8*)(Q + qk_off(b, h, q0 + r32, 2 * s + hi));
    const int NT = 4 * (qb + 1), tlast = 4 * qb + (w >> 1);
    const char* kbase = (const char*)K + (size_t)((b * NH + h) * 128) * KTB;
    const char* vbase = (const char*)VT + (size_t)((b * NH + h) * 128) * VTB;
#define ATT_ISSUE(t, bsel) do { _Pragma("unroll") for (int j_ = 0; j_ < 3; ++j_) { const int i_ = w + 8 * j_; if (i_ < 20) { \
        const char* src_ = (i_ < 12) ? kbase + (size_t)(t) * KTB + i_ * 1024 : vbase + (size_t)(t) * VTB + (i_ - 12) * 1024; \
        __builtin_amdgcn_global_load_lds((const unsigned*)(src_ + lane * 16), (LAS unsigned*)(lds + (bsel) * BUFB + i_ * 1024), 16, 0, 0); } } } while (0)
    f32x16 o0, o1;
#pragma unroll
    for (int r = 0; r < 16; ++r) { o0[r] = 0.f; o1[r] = 0.f; }
    float m_run = -1e30f, l_run = 0.f;
    ATT_ISSUE(0, 0);
#pragma unroll 1
    for (int t = 0; t < NT; ++t) {
        asm volatile("s_waitcnt vmcnt(0)" ::: "memory"); __builtin_amdgcn_s_barrier(); asm volatile("" ::: "memory");
        if (t + 1 < NT) ATT_ISSUE(t + 1, (t + 1) & 1);
        if (t <= tlast) {
            const LAS unsigned char* kb = lds + (t & 1) * BUFB; const LAS unsigned char* vb = kb + KTB;
            f32x16 p0, p1;
#pragma unroll
            for (int r = 0; r < 16; ++r) { p0[r] = 0.f; p1[r] = 0.f; }
#pragma unroll
            for (int s = 0; s < 6; ++s) {
                const bf16x8 k0 = *(const LAS bf16x8*)(kb + ((2 * s + hi) * 64 + r32) * 16), k1 = *(const LAS bf16x8*)(kb + ((2 * s + hi) * 64 + 32 + r32) * 16);
                p0 = ATT_MFMA(k0, qf[s], p0); p1 = ATT_MFMA(k1, qf[s], p1);
            }
            if (t == tlast) { const int qg = q0 + r32, kg = 64 * t + 4 * hi;
#pragma unroll
                for (int r = 0; r < 16; ++r) { const int key = kg + (r & 3) + 8 * (r >> 2); if (key > qg) p0[r] = -INFINITY; if (key + 32 > qg) p1[r] = -INFINITY; } }
            float mx = fmaxf(p0[0], p1[0]);
#pragma unroll
            for (int r = 1; r < 16; ++r) mx = fmaxf(mx, fmaxf(p0[r], p1[r]));
            mx = fmaxf(mx, __shfl_xor(mx, 32));
            const float m_new = fmaxf(m_run, mx), alpha = __builtin_amdgcn_exp2f(m_run - m_new); m_run = m_new;
            float rs = 0.f;
#pragma unroll
            for (int r = 0; r < 16; ++r) { p0[r] = __builtin_amdgcn_exp2f(p0[r] - m_new); p1[r] = __builtin_amdgcn_exp2f(p1[r] - m_new); rs += p0[r] + p1[r]; }
            l_run = l_run * alpha + rs;
#pragma unroll
            for (int r = 0; r < 16; ++r) { o0[r] *= alpha; o1[r] *= alpha; }
            u32x4 pw[4];
#pragma unroll
            for (int i = 0; i < 4; ++i) { pw[0][i] = cvtpk(p0[2 * i], p0[2 * i + 1]); pw[1][i] = cvtpk(p0[8 + 2 * i], p0[9 + 2 * i]); pw[2][i] = cvtpk(p1[2 * i], p1[2 * i + 1]); pw[3][i] = cvtpk(p1[8 + 2 * i], p1[9 + 2 * i]); }
#pragma unroll
            for (int s = 0; s < 4; ++s) {
                const bf16x8 v0 = *(const LAS bf16x8*)(vb + ((2 * s + hi) * 64 + r32) * 16), v1 = *(const LAS bf16x8*)(vb + ((2 * s + hi) * 64 + 32 + r32) * 16);
                const bf16x8 pf = __builtin_bit_cast(bf16x8, pw[s]);
                o0 = ATT_MFMA(v0, pf, o0); o1 = ATT_MFMA(v1, pf, o1);
            }
        }
    }
    const float l_tot = l_run + __shfl_xor(l_run, 32), inv = 1.f / l_tot;
    bf16_t* orow = ycat + (size_t)(b * SEQ + q0 + r32) * DM + 512 + h * 64 + 4 * hi;
#pragma unroll
    for (int g = 0; g < 4; ++g) {
        u32x2 a, c; a.x = cvtpk(o0[4 * g] * inv, o0[4 * g + 1] * inv); a.y = cvtpk(o0[4 * g + 2] * inv, o0[4 * g + 3] * inv);
        c.x = cvtpk(o1[4 * g] * inv, o1[4 * g + 1] * inv); c.y = cvtpk(o1[4 * g + 2] * inv, o1[4 * g + 3] * inv);
        *(u32x2*)(orow + 8 * g) = a; *(u32x2*)(orow + 32 + 8 * g) = c;
    }
    asm volatile("s_waitcnt lgkmcnt(0)" ::: "memory"); __builtin_amdgcn_s_barrier(); asm volatile("" ::: "memory");
#undef ATT_ISSUE
}
__device__ __forceinline__ void attn_phase(LAS unsigned char* lds, int vcu, int G, const bf16_t* Q, const bf16_t* K, const bf16_t* VT, bf16_t* ycat) {
    for (int idx = vcu; idx < NB * NH * 16; idx += G) { const int bh = idx >> 4, s = idx & 15;
        attn_unit(lds, bh >> 3, bh & 7, 31 - s, Q, K, VT, ycat);
        attn_unit(lds, bh >> 3, bh & 7, s, Q, K, VT, ycat); }
}
}

namespace ssd {
using att::f32x16; using att::cvtpk;
constexpr int PITCH = 272;
constexpr int L_CM = 0, L_BM = 34816, L_BWT = 69632, L_XT = 104448, L_SDT = 121856, L_SACUM = L_SDT + 512, L_END = L_SACUM + 512;
constexpr int F_CM = 0, F_SAC = 34816, F_TMP = F_SAC + 2048, F_PART = F_TMP + 2048, F_END = F_PART + 4096;
#define SSD_MFMA(a, b, c) __builtin_amdgcn_mfma_f32_32x32x16_bf16((a), (b), (c), 0, 0, 0)
__device__ __forceinline__ int qpos(int s) { return (s & ~12) | ((s & 4) << 1) | ((s & 8) >> 1); }
__device__ __forceinline__ float softplus(float v) { return v > 20.f ? v : log1pf(__expf(v)); }
__device__ __forceinline__ int crow(int r, int hi) { return (r & 3) + 8 * (r >> 2) + 4 * hi; }

__device__ __forceinline__ void conv_item(const bf16_t* __restrict__ proj, const float* __restrict__ cw, const float* __restrict__ cb, int b, int c, int ch0, int l0, float (&out)[4][8]) {
    float w[4][8], bias[8];
#pragma unroll
    for (int k = 0; k < 4; ++k) { const f32x4 w0 = *(const f32x4*)(cw + k * 1024 + ch0), w1 = *(const f32x4*)(cw + k * 1024 + ch0 + 4); w[k][0] = w0[0]; w[k][1] = w0[1]; w[k][2] = w0[2]; w[k][3] = w0[3]; w[k][4] = w1[0]; w[k][5] = w1[1]; w[k][6] = w1[2]; w[k][7] = w1[3]; }
    { const f32x4 b0 = *(const f32x4*)(cb + ch0), b1 = *(const f32x4*)(cb + ch0 + 4); bias[0] = b0[0]; bias[1] = b0[1]; bias[2] = b0[2]; bias[3] = b0[3]; bias[4] = b1[0]; bias[5] = b1[1]; bias[6] = b1[2]; bias[7] = b1[3]; }
#pragma unroll
    for (int i = 0; i < 4; ++i)
#pragma unroll
        for (int j = 0; j < 8; ++j) out[i][j] = bias[j];
    const int t0 = c * CHUNK + l0;
#pragma unroll
    for (int rr = 0; rr < 7; ++rr) {
        const int t = t0 - 3 + rr; float in[8];
        if (t >= 0) load8(proj + (size_t)(b * SEQ + t) * 1536 + 512 + ch0, in);
        else {
#pragma unroll
            for (int j = 0; j < 8; ++j) in[j] = 0.f; }
#pragma unroll
        for (int k = 0; k < 4; ++k) { const int i = rr - k; if (i >= 0 && i < 4) {
#pragma unroll
            for (int j = 0; j < 8; ++j) out[i][j] += w[k][j] * in[j]; } }
    }
#pragma unroll
    for (int i = 0; i < 4; ++i)
#pragma unroll
        for (int j = 0; j < 8; ++j) out[i][j] = silu(out[i][j]);
}
__device__ __forceinline__ void scan128(const LAS float* src, LAS float* dst, int lane) {
    const float v0 = src[2 * lane], v1 = src[2 * lane + 1]; const float s = v0 + v1; float incl = s;
#pragma unroll
    for (int o = 1; o < 64; o <<= 1) { const float t = __shfl_up(incl, o); if (lane >= o) incl += t; }
    const float excl = incl - s; dst[2 * lane] = excl + v0; dst[2 * lane + 1] = excl + s;
}
#define SSD_BAR() do { asm volatile("s_waitcnt lgkmcnt(0)" ::: "memory"); __builtin_amdgcn_s_barrier(); asm volatile("" ::: "memory"); } while (0)

__device__ __forceinline__ void chunk_unit(LAS unsigned char* lds, int b, int c, int h, const bf16_t* __restrict__ proj, const float* __restrict__ dtr, const float* __restrict__ cw, const float* __restrict__ cb,
                                           const float* __restrict__ dt_bias, const float* __restrict__ a_log, const float* __restrict__ d_skip, float* __restrict__ Y, float* __restrict__ states, float* __restrict__ cd) {
    const int tid = threadIdx.x, lane = tid & 63, r32 = lane & 31, hi = lane >> 5, w = __builtin_amdgcn_readfirstlane(tid >> 6);
    const int g = h >> 2, tok0 = b * SEQ + c * CHUNK;
    LAS float* sdt = (LAS float*)(lds + L_SDT); LAS float* sacum = (LAS float*)(lds + L_SACUM);
    const float a = -__expf(a_log[h]);
    if (tid < 128) { const float dt = softplus(dtr[(size_t)(tok0 + tid) * 8 + h] + dt_bias[h]); sdt[tid] = dt; sacum[tid] = dt * a; }
    SSD_BAR();
    if (w == 0) scan128(sacum, sacum, lane);
    SSD_BAR();
    const float aend = sacum[127];
    if (tid == 0) cd[(b * 64 + c) * 8 + h] = __expf(aend);
    for (int item = tid; item < 40 * 32; item += NTHR) {
        const int cg = item >> 5, l0 = (item & 31) * 4; float o[4][8];
        if (cg < 8) {
            conv_item(proj, cw, cb, b, c, h * 64 + cg * 8, l0, o);
#pragma unroll
            for (int i = 0; i < 4; ++i) { const int q = qpos(l0 + i);
#pragma unroll
                for (int j = 0; j < 8; ++j) *(LAS bf16_t*)(lds + L_XT + (cg * 8 + j) * PITCH + q * 2) = (bf16_t)f2bf(o[i][j]); }
        } else if (cg < 24) {
            const int n0 = (cg - 8) * 8; conv_item(proj, cw, cb, b, c, 512 + g * 128 + n0, l0, o);
#pragma unroll
            for (int i = 0; i < 4; ++i) { const int s = l0 + i, q = qpos(s); const float wl = sdt[s] * __expf(aend - sacum[s]);
                u32x4 pk; pk.x = pk2(o[i][0], o[i][1]); pk.y = pk2(o[i][2], o[i][3]); pk.z = pk2(o[i][4], o[i][5]); pk.w = pk2(o[i][6], o[i][7]);
                *(LAS u32x4*)(lds + L_BM + s * PITCH + n0 * 2) = pk;
#pragma unroll
                for (int j = 0; j < 8; ++j) *(LAS bf16_t*)(lds + L_BWT + (n0 + j) * PITCH + q * 2) = (bf16_t)f2bf(o[i][j] * wl); }
        } else {
            const int n0 = (cg - 24) * 8; conv_item(proj, cw, cb, b, c, 768 + g * 128 + n0, l0, o);
#pragma unroll
            for (int i = 0; i < 4; ++i) { u32x4 pk; pk.x = pk2(o[i][0], o[i][1]); pk.y = pk2(o[i][2], o[i][3]); pk.z = pk2(o[i][4], o[i][5]); pk.w = pk2(o[i][6], o[i][7]);
                *(LAS u32x4*)(lds + L_CM + (l0 + i) * PITCH + n0 * 2) = pk; }
        }
    }
    SSD_BAR();
    const int lb = w & 3, pb = w >> 2;
    f32x16 yacc;
#pragma unroll
    for (int r = 0; r < 16; ++r) yacc[r] = 0.f;
    const float acl = sacum[lb * 32 + r32];
#pragma unroll 1
    for (int sb = 0; sb <= lb; ++sb) {
        f32x16 X;
#pragma unroll
        for (int r = 0; r < 16; ++r) X[r] = 0.f;
#pragma unroll
        for (int ks = 0; ks < 8; ++ks) {
            const bf16x8 af = *(const LAS bf16x8*)(lds + L_BM + (sb * 32 + r32) * PITCH + (16 * ks + 8 * hi) * 2);
            const bf16x8 bfr = *(const LAS bf16x8*)(lds + L_CM + (lb * 32 + r32) * PITCH + (16 * ks + 8 * hi) * 2);
            X = SSD_MFMA(af, bfr, X);
        }
        float mv[16];
#pragma unroll
        for (int gq = 0; gq < 4; ++gq) { const int sb0 = sb * 32 + 8 * gq + 4 * hi; const f32x4 ac = *(const LAS f32x4*)(sacum + sb0), dv = *(const LAS f32x4*)(sdt + sb0);
#pragma unroll
            for (int i = 0; i < 4; ++i) { const float val = X[4 * gq + i] * __expf(acl - ac[i]) * dv[i]; const bool masked = (sb == lb) && (8 * gq + 4 * hi + i > r32); mv[4 * gq + i] = masked ? 0.f : val; } }
        u32x4 pw0, pw1;
#pragma unroll
        for (int i = 0; i < 4; ++i) { pw0[i] = cvtpk(mv[2 * i], mv[2 * i + 1]); pw1[i] = cvtpk(mv[8 + 2 * i], mv[9 + 2 * i]); }
        const bf16x8 x0 = *(const LAS bf16x8*)(lds + L_XT + (pb * 32 + r32) * PITCH + (32 * sb + 8 * hi) * 2), x1 = *(const LAS bf16x8*)(lds + L_XT + (pb * 32 + r32) * PITCH + (32 * sb + 16 + 8 * hi) * 2);
        yacc = SSD_MFMA(x0, __builtin_bit_cast(bf16x8, pw0), yacc);
        yacc = SSD_MFMA(x1, __builtin_bit_cast(bf16x8, pw1), yacc);
    }
    f32x16 st;
#pragma unroll
    for (int r = 0; r < 16; ++r) st[r] = 0.f;
#pragma unroll
    for (int ks = 0; ks < 8; ++ks) {
        const bf16x8 af = *(const LAS bf16x8*)(lds + L_BWT + (lb * 32 + r32) * PITCH + (16 * ks + 8 * hi) * 2);
        const bf16x8 bfr = *(const LAS bf16x8*)(lds + L_XT + (pb * 32 + r32) * PITCH + (16 * ks + 8 * hi) * 2);
        st = SSD_MFMA(af, bfr, st);
    }
    { const float dsk = d_skip[h]; const int l = lb * 32 + r32, ql = qpos(l); float* yrow = Y + (size_t)(tok0 + l) * 512 + h * 64 + pb * 32 + 4 * hi;
#pragma unroll
      for (int gq = 0; gq < 4; ++gq) { f32x4 o;
#pragma unroll
        for (int i = 0; i < 4; ++i) { const int p = pb * 32 + 8 * gq + 4 * hi + i; o[i] = yacc[4 * gq + i] + dsk * bf2f(*(const LAS bf16_t*)(lds + L_XT + p * PITCH + ql * 2)); }
        *(f32x4*)(yrow + 8 * gq) = o; }
      float* srow = states + ((size_t)((b * 64 + c) * 8 + h) * 64 + pb * 32 + r32) * 128 + lb * 32 + 4 * hi;
#pragma unroll
      for (int gq = 0; gq < 4; ++gq) *(f32x4*)(srow + 8 * gq) = (f32x4){st[4 * gq], st[4 * gq + 1], st[4 * gq + 2], st[4 * gq + 3]}; }
    SSD_BAR();
}

__device__ __forceinline__ void scan_phase(int vcu, int G, float* __restrict__ states, const float* __restrict__ cd) {
    for (int gid = vcu * NTHR + threadIdx.x; gid < NB * 65536; gid += G * NTHR) {
        const int b = gid >> 16, rem = gid & 65535, h = rem >> 13; float* p = states + (size_t)b * 64 * 65536 + rem; const float* cdp = cd + b * 64 * 8 + h;
        float hs = 0.f;
#pragma unroll 1
        for (int c0 = 0; c0 < 64; c0 += 8) { float s[8], d[8];
#pragma unroll
            for (int i = 0; i < 8; ++i) { s[i] = p[(size_t)(c0 + i) * 65536]; d[i] = cdp[(c0 + i) * 8]; }
#pragma unroll
            for (int i = 0; i < 8; ++i) { p[(size_t)(c0 + i) * 65536] = hs; hs = hs * d[i] + s[i]; } }
    }
}

__device__ __forceinline__ void final_unit(LAS unsigned char* lds, int b, int c, int g, const bf16_t* __restrict__ proj, const float* __restrict__ dtr, const float* __restrict__ cw, const float* __restrict__ cb,
                                           const float* __restrict__ dt_bias, const float* __restrict__ a_log, const float* __restrict__ ng, const float* __restrict__ Y, const float* __restrict__ states, bf16_t* __restrict__ ycat) {
    const int tid = threadIdx.x, lane = tid & 63, r32 = lane & 31, hi = lane >> 5, w = __builtin_amdgcn_readfirstlane(tid >> 6);
    const int tok0 = b * SEQ + c * CHUNK;
    LAS float* sac = (LAS float*)(lds + F_SAC); LAS float* tmp = (LAS float*)(lds + F_TMP); LAS float* part = (LAS float*)(lds + F_PART);
    { const int j = tid >> 7, l = tid & 127, hh = 4 * g + j; const float dt = softplus(dtr[(size_t)(tok0 + l) * 8 + hh] + dt_bias[hh]); tmp[j * 128 + l] = dt * (-__expf(a_log[hh])); }
    SSD_BAR();
    if (w < 4) scan128(tmp + w * 128, sac + w * 128, lane);
    { const int cgi = tid >> 5, l0 = (tid & 31) * 4, n0 = cgi * 8; float o[4][8];
      conv_item(proj, cw, cb, b, c, 768 + g * 128 + n0, l0, o);
#pragma unroll
      for (int i = 0; i < 4; ++i) { u32x4 pk; pk.x = pk2(o[i][0], o[i][1]); pk.y = pk2(o[i][2], o[i][3]); pk.z = pk2(o[i][4], o[i][5]); pk.w = pk2(o[i][6], o[i][7]);
          *(LAS u32x4*)(lds + F_CM + (l0 + i) * PITCH + n0 * 2) = pk; } }
    SSD_BAR();
    const int j = w >> 1, pb = w & 1, head = 4 * g + j;
    bf16x8 af[8];
    { const float* sp = states + ((size_t)((b * 64 + c) * 8 + head) * 64 + pb * 32 + r32) * 128 + 8 * hi;
#pragma unroll
      for (int ks = 0; ks < 8; ++ks) { const f32x4 s0 = *(const f32x4*)(sp + 16 * ks), s1 = *(const f32x4*)(sp + 16 * ks + 4); u32x4 pk; pk.x = cvtpk(s0[0], s0[1]); pk.y = cvtpk(s0[2], s0[3]); pk.z = cvtpk(s1[0], s1[1]); pk.w = cvtpk(s1[2], s1[3]); af[ks] = __builtin_bit_cast(bf16x8, pk); } }
    float yv[4][16];
#pragma unroll
    for (int lb = 0; lb < 4; ++lb) {
        f32x16 acc;
#pragma unroll
        for (int r = 0; r < 16; ++r) acc[r] = 0.f;
#pragma unroll
        for (int ks = 0; ks < 8; ++ks) { const bf16x8 bfr = *(const LAS bf16x8*)(lds + F_CM + (lb * 32 + r32) * PITCH + (16 * ks + 8 * hi) * 2); acc = SSD_MFMA(af[ks], bfr, acc); }
        const int l = lb * 32 + r32; const float e = __expf(sac[j * 128 + l]); float ss = 0.f;
        const float* yrow = Y + (size_t)(tok0 + l) * 512 + head * 64 + pb * 32 + 4 * hi; const bf16_t* zrow = proj + (size_t)(tok0 + l) * 1536 + head * 64 + pb * 32 + 4 * hi;
#pragma unroll
        for (int gq = 0; gq < 4; ++gq) { const f32x4 yd = *(const f32x4*)(yrow + 8 * gq); const u32x2 zz = *(const u32x2*)(zrow + 8 * gq);
            const float z[4] = {__uint_as_float(zz.x << 16), __uint_as_float(zz.x & 0xffff0000u), __uint_as_float(zz.y << 16), __uint_as_float(zz.y & 0xffff0000u)};
#pragma unroll
            for (int i = 0; i < 4; ++i) { const float v = (acc[4 * gq + i] * e + yd[i]) * silu(z[i]); yv[lb][4 * gq + i] = v; ss += v * v; } }
        ss += __shfl_xor(ss, 32);
        if (hi == 0) part[l * 8 + w] = ss;
    }
    SSD_BAR();
#pragma unroll
    for (int lb = 0; lb < 4; ++lb) { const int l = lb * 32 + r32; const f32x4 p0 = *(const LAS f32x4*)(part + l * 8), p1 = *(const LAS f32x4*)(part + l * 8 + 4);
        const float rstd = rsqrtf(((p0[0] + p0[1]) + (p0[2] + p0[3]) + (p1[0] + p1[1]) + (p1[2] + p1[3])) * (1.f / 256.f) + EPS);
        bf16_t* orow = ycat + (size_t)(tok0 + l) * DM + head * 64 + pb * 32 + 4 * hi; const float* gp = ng + head * 64 + pb * 32 + 4 * hi;
#pragma unroll
        for (int gq = 0; gq < 4; ++gq) { const f32x4 gg = *(const f32x4*)(gp + 8 * gq); u32x2 o; o.x = cvtpk(yv[lb][4 * gq] * rstd * gg[0], yv[lb][4 * gq + 1] * rstd * gg[1]); o.y = cvtpk(yv[lb][4 * gq + 2] * rstd * gg[2], yv[lb][4 * gq + 3] * rstd * gg[3]);
            *(u32x2*)(orow + 8 * gq) = o; } }
    SSD_BAR();
}
}

__device__ __forceinline__ void router_phase(LAS float* hvs, int gw, int NGW, int lane, const float* __restrict__ x1, const float* __restrict__ g, const float* __restrict__ wr, const float* __restrict__ br, bf16_t* __restrict__ h2,
                                             u32* __restrict__ cnt, int* __restrict__ list, float* __restrict__ listg, int* __restrict__ toke, int* __restrict__ tokp) {
#pragma unroll 1
    for (int tok = gw; tok < NTOK; tok += NGW) {
        const f32x4* xr = (const f32x4*)(x1 + (size_t)tok * DM) + lane; f32x4 v[4]; float ss = 0.f;
#pragma unroll
        for (int j = 0; j < 4; ++j) { v[j] = xr[64 * j]; ss += v[j].x * v[j].x + v[j].y * v[j].y + v[j].z * v[j].z + v[j].w * v[j].w; }
        const float r = rsqrtf(wave_sum(ss) * (1.f / DM) + EPS);
        float lg[32];
#pragma unroll
        for (int e = 0; e < 32; ++e) lg[e] = 0.f;
#pragma unroll
        for (int j = 0; j < 4; ++j) { const f32x4 gg = ((const f32x4*)g)[lane + 64 * j]; const float hv[4] = {v[j].x * r * gg.x, v[j].y * r * gg.y, v[j].z * r * gg.z, v[j].w * r * gg.w};
            u32x2 w; w.x = pk2(hv[0], hv[1]); w.y = pk2(hv[2], hv[3]); *(u32x2*)(h2 + (size_t)tok * DM + 4 * (lane + 64 * j)) = w;
            *(LAS f32x4*)(hvs + (j * 64 + lane) * 4) = (f32x4){hv[0], hv[1], hv[2], hv[3]}; }
        asm volatile("s_waitcnt lgkmcnt(0)" ::: "memory");
#pragma unroll 2
        for (int k = 0; k < 16; ++k) { const float hvk = hvs[((k >> 2) * 64 + lane) * 4 + (k & 3)]; const f32x4* wp = (const f32x4*)(wr + (size_t)(4 * (lane + 64 * (k >> 2)) + (k & 3)) * NE);
#pragma unroll
            for (int e4 = 0; e4 < 8; ++e4) { const f32x4 ww = wp[e4]; lg[4 * e4] += hvk * ww.x; lg[4 * e4 + 1] += hvk * ww.y; lg[4 * e4 + 2] += hvk * ww.z; lg[4 * e4 + 3] += hvk * ww.w; } }
#pragma unroll
        for (int e = 0; e < 32; ++e) lg[e] = wave_sum(lg[e]) + br[e];
        int sel[4]; float sv[4];
#pragma unroll
        for (int k = 0; k < 4; ++k) { float best = -3.0e38f; int bi = 0;
#pragma unroll
            for (int e = 0; e < 32; ++e) if (lg[e] > best) { best = lg[e]; bi = e; }
            sel[k] = bi; sv[k] = best;
#pragma unroll
            for (int e = 0; e < 32; ++e) if (e == bi) lg[e] = -3.0e38f; }
        const float e1 = __expf(sv[1] - sv[0]), e2 = __expf(sv[2] - sv[0]), e3 = __expf(sv[3] - sv[0]), inv = 1.f / (1.f + e1 + e2 + e3);
        const float gwt[4] = {inv, e1 * inv, e2 * inv, e3 * inv};
        if (lane == 0) {
#pragma unroll
            for (int k = 0; k < 4; ++k) { const int e = sel[k]; const u32 p = atomicAdd(cnt + e, 1u); list[(size_t)e * NTOK + p] = tok; listg[(size_t)e * NTOK + p] = gwt[k]; toke[tok * 4 + k] = e; tokp[tok * 4 + k] = (int)p; }
        }
    }
}
__device__ __forceinline__ void combine_phase(int gw, int NGW, int lane, const float* __restrict__ x1, const bf16_t* __restrict__ ys, const u32* __restrict__ cnt, const int* __restrict__ toke, const int* __restrict__ tokp, const float* __restrict__ g, float* __restrict__ out) {
    int tiles = lane < 32 ? (int)((cnt[lane & 31] + 255) >> 8) : 0, incl = tiles;
#pragma unroll
    for (int o = 1; o < 32; o <<= 1) { const int t = __shfl_up(incl, o); if ((lane & 31) >= o) incl += t; }
    const int excl = (incl - tiles) << 8;
#pragma unroll 1
    for (int tok = gw; tok < NTOK; tok += NGW) {
        f32x4 v[4];
#pragma unroll
        for (int j = 0; j < 4; ++j) v[j] = ((const f32x4*)(x1 + (size_t)tok * DM))[lane + 64 * j];
#pragma unroll
        for (int k = 0; k < 4; ++k) { const int e = toke[tok * 4 + k], p = tokp[tok * 4 + k]; const int srow = __shfl(excl, e) + p; const bf16_t* yr = ys + (size_t)srow * DM;
#pragma unroll
            for (int j = 0; j < 4; ++j) { const u32x2 w = *(const u32x2*)(yr + 4 * (lane + 64 * j));
                v[j].x += __uint_as_float(w.x << 16); v[j].y += __uint_as_float(w.x & 0xffff0000u); v[j].z += __uint_as_float(w.y << 16); v[j].w += __uint_as_float(w.y & 0xffff0000u); } }
        float ss = 0.f;
#pragma unroll
        for (int j = 0; j < 4; ++j) ss += v[j].x * v[j].x + v[j].y * v[j].y + v[j].z * v[j].z + v[j].w * v[j].w;
        const float r = rsqrtf(wave_sum(ss) * (1.f / DM) + EPS);
#pragma unroll
        for (int j = 0; j < 4; ++j) { const f32x4 gg = ((const f32x4*)g)[lane + 64 * j]; ((f32x4*)(out + (size_t)tok * DM))[lane + 64 * j] = (f32x4){v[j].x * r * gg.x, v[j].y * r * gg.y, v[j].z * r * gg.z, v[j].w * r * gg.w}; }
    }
}

struct Frame { LAS unsigned char* lds; int tid, lane, wave, G, vcu; };

__device__ __forceinline__ void p0_prologue(const Frame& F, const Args& a) {
    unsigned char* ws = a.ws;
    const int gw = F.vcu * NWAVES + F.wave, NGW = F.G * NWAVES;
    constexpr int T_IN = 16 * 32, T_UQ = 4 * 12, T_KN = 2 * 8, T_V = 2 * 8, T_OUT = 16 * 16, T_GU = 16 * 32, T_DN = 16 * 16;
    constexpr int NT = T_IN + T_UQ + T_KN + T_V + T_OUT + NE * T_GU + NE * T_DN;
    for (int it = gw; it < NT; it += NGW) {
        int r = it;
        if (r < T_IN) { p0_tile((const float*)a.in[3], IN_W, 1024, nullptr, (bf16_t*)(ws + WS_WIN), (r >> 5) * 64, (r & 31) * 64, MapIn{}, F.lane); continue; } r -= T_IN;
        if (r < T_UQ) { p0_tile((const float*)a.in[11], 768, 256, (const float*)a.in[10], (bf16_t*)(ws + WS_WUQ), (r / 12) * 64, (r % 12) * 64, MapQ{}, F.lane); continue; } r -= T_UQ;
        if (r < T_KN) { p0_tile((const float*)a.in[13], 1024, 128, (const float*)a.in[12], (bf16_t*)(ws + WS_WKN), (r >> 3) * 64, (r & 7) * 64, MapKn{}, F.lane); continue; } r -= T_KN;
        if (r < T_V) { p0_tile((const float*)a.in[13], 1024, 128, (const float*)a.in[12], (bf16_t*)(ws + WS_WV), (r >> 3) * 64, (r & 7) * 64, MapV{}, F.lane); continue; } r -= T_V;
        if (r < T_OUT) { p0_tile((const float*)a.in[14], 1024, 1024, nullptr, (bf16_t*)(ws + WS_WOUT), (r >> 4) * 64, (r & 15) * 64, MapId{}, F.lane); continue; } r -= T_OUT;
        if (r < NE * T_GU) { const int e = r / T_GU, q = r % T_GU; p0_tile((const float*)a.in[18] + (size_t)e * 1024 * 2048, 2048, 1024, nullptr, (bf16_t*)(ws + WS_WGU) + (size_t)e * 2048 * 1024, (q >> 5) * 64, (q & 31) * 64, MapGU{}, F.lane); continue; } r -= NE * T_GU;
        { const int e = r / T_DN, q = r % T_DN; p0_tile((const float*)a.in[20] + (size_t)e * 1024 * 1024, 1024, 1024, nullptr, (bf16_t*)(ws + WS_WDN) + (size_t)e * 1024 * 1024, (q >> 4) * 64, (q & 15) * 64, MapId{}, F.lane); }
    }
    { const float* x = (const float*)a.in[0]; const float* g = (const float*)a.in[2]; bf16_t* H = (bf16_t*)(ws + WS_H);
      for (int row = gw; row < NTOK; row += NGW) {
        const f32x4* xr = (const f32x4*)(x + (size_t)row * DM) + F.lane; f32x4 v[4]; float ss = 0.f;
#pragma unroll
        for (int j = 0; j < 4; ++j) { v[j] = xr[64 * j]; ss += v[j].x * v[j].x + v[j].y * v[j].y + v[j].z * v[j].z + v[j].w * v[j].w; }
        const float r = rsqrtf(wave_sum(ss) * (1.f / DM) + EPS);
#pragma unroll
        for (int j = 0; j < 4; ++j) { const f32x4 gg = ((const f32x4*)g)[F.lane + 64 * j]; u32x2 w; w.x = pk2(v[j].x * r * gg.x, v[j].y * r * gg.y); w.y = pk2(v[j].z * r * gg.z, v[j].w * r * gg.w);
            *(u32x2*)(H + (size_t)row * DM + 4 * (F.lane + 64 * j)) = w; }
      } }
    { const int* pos = (const int*)a.in[1]; float* rc = (float*)(ws + WS_ROPEC); float* rs = (float*)(ws + WS_ROPES);
      for (int idx = F.vcu * NTHR + F.tid; idx < NTOK * 16; idx += F.G * NTHR) { const int tok = idx >> 4, i = idx & 15;
        double t = (double)pos[tok] * INVF2PI[i]; t -= floor(t); const float fr = (float)t; rc[idx] = __builtin_amdgcn_cosf(fr); rs[idx] = __builtin_amdgcn_sinf(fr); } }
}

__global__ void __launch_bounds__(NTHR, 2) mega(Args args) {
    extern __shared__ __attribute__((aligned(16))) unsigned char lds_raw[];
    Frame F; F.lds = (LAS unsigned char*)lds_raw;
    F.tid = threadIdx.x; F.lane = F.tid & 63; F.wave = __builtin_amdgcn_readfirstlane(F.tid >> 6);
    F.G = gridDim.x; { const int bx = blockIdx.x; F.vcu = (F.G % 8 == 0) ? (bx % 8) * (F.G / 8) + bx / 8 : bx; }
    volatile LAS unsigned* MISC = (volatile LAS unsigned*)(F.lds + MISC_OFF);
    for (int u = F.tid; u < (LDS_BYTES - LDSCTL_OFF) / 4; u += NTHR) ((LAS unsigned*)(F.lds + LDSCTL_OFF))[u] = 0u;
    __syncthreads();
    unsigned char* ws = args.ws;
    unsigned* ctl = (unsigned*)(ws + WS_CTL);
    const int lo = args.ph_lo, hi = args.ph_hi;
    XcdBarrier bar; bar.bar = ctl + CW_BAR; bar.x = 0; bar.st = nullptr;
    if (hi - lo > 1) bar = xcd_barrier_post(ctl + CW_BAR, MISC + 8);
#define IN(k) (lo <= (k) && (k) < hi)
#define SEAM(k) do { if (IN(k) && IN((k) + 1)) xcd_barrier(bar); } while (0)

    if (IN(0)) { p0_prologue(F, args); } SEAM(0);
    if (IN(1)) {
        pg8::GridOrder S{(const char*)(ws + WS_H), (const char*)(ws + WS_WIN), 1024, NTOK / 256, 2048 / 256, F.G, F.vcu, 0};
        pg8::EpiInprojMfma E{EpiInproj{(bf16_t*)(ws + WS_PROJ), (bf16_t*)(ws + WS_CQ), (bf16_t*)(ws + WS_CKV), (float*)(ws + WS_DT), (bf16_t*)(ws + WS_K), (const float*)(ws + WS_ROPEC), (const float*)(ws + WS_ROPES)},
                             (float*)(ws + WS_PARTQ), (float*)(ws + WS_PARTKV), (LAS float*)(F.lds + LDSCTL_OFF + 1024)};
        pg8::gemm_phase(F.lds, 1024, S, E);
    } SEAM(1);
    if (IN(2)) {
        { pg8::GridOrderRot S{(const char*)(ws + WS_CQ), (const char*)(ws + WS_WUQ), 256, NTOK / 256, 3, F.G, F.vcu, 0};
          pg8::EpiRows<EpiQ> E{EpiQ{(bf16_t*)(ws + WS_Q), (const float*)(ws + WS_PARTQ), (const float*)(ws + WS_ROPEC), (const float*)(ws + WS_ROPES)}};
          pg8::gemm_phase(F.lds, 256, S, E); }
        { pg8::GridOrderRot S{(const char*)(ws + WS_CKV), (const char*)(ws + WS_WKN), 128, NTOK / 256, 2, F.G, F.vcu, 192};
          pg8::EpiRows<EpiKn> E{EpiKn{(bf16_t*)(ws + WS_K), (const float*)(ws + WS_PARTKV)}};
          pg8::gemm_phase(F.lds, 128, S, E); }
        { pg8::GridOrderRot S{(const char*)(ws + WS_WV), (const char*)(ws + WS_CKV), 128, 2, NTOK / 256, F.G, F.vcu, 64};
          pg8::EpiColsVt E{(bf16_t*)(ws + WS_VT), (const float*)(ws + WS_PARTKV)};
          pg8::gemm_phase(F.lds, 128, S, E); }
        for (int u = F.vcu; u < NB * 64 * NH; u += F.G)
            ssd::chunk_unit(F.lds, u >> 9, (u >> 3) & 63, u & 7, (const bf16_t*)(ws + WS_PROJ), (const float*)(ws + WS_DT), (const float*)args.in[4], (const float*)args.in[5], (const float*)args.in[6], (const float*)args.in[7], (const float*)args.in[8],
                            (float*)(ws + WS_Y), (float*)(ws + WS_STATES), (float*)(ws + WS_CD));
    } SEAM(2);
    if (IN(3)) { ssd::scan_phase(F.vcu, F.G, (float*)(ws + WS_STATES), (const float*)(ws + WS_CD)); } SEAM(3);
    if (IN(4)) {
        for (int u = F.vcu; u < NB * 64 * NG; u += F.G)
            ssd::final_unit(F.lds, u >> 7, (u >> 1) & 63, u & 1, (const bf16_t*)(ws + WS_PROJ), (const float*)(ws + WS_DT), (const float*)args.in[4], (const float*)args.in[5], (const float*)args.in[6], (const float*)args.in[7], (const float*)args.in[9],
                            (const float*)(ws + WS_Y), (const float*)(ws + WS_STATES), (bf16_t*)(ws + WS_YCAT));
        att::attn_phase(F.lds, F.vcu, F.G, (const bf16_t*)(ws + WS_Q), (const bf16_t*)(ws + WS_K), (const bf16_t*)(ws + WS_VT), (bf16_t*)(ws + WS_YCAT));
    } SEAM(4);
    if (IN(5)) {
        pg8::GridOrder S{(const char*)(ws + WS_YCAT), (const char*)(ws + WS_WOUT), 1024, NTOK / 256, 4, F.G, F.vcu, 0};
        pg8::EpiRows<EpiOut> E{EpiOut{(const float*)args.in[0], (float*)(ws + WS_X1)}};
        pg8::gemm_phase(F.lds, 1024, S, E);
    } SEAM(5);
    if (IN(6)) { router_phase((LAS float*)(F.lds + F.wave * 4096), F.vcu * NWAVES + F.wave, F.G * NWAVES, F.lane, (const float*)(ws + WS_X1), (const float*)args.in[15], (const float*)args.in[16], (const float*)args.in[17], (bf16_t*)(ws + WS_H2),
                              (u32*)(ctl + CW_CNT), (int*)(ws + WS_LIST), (float*)(ws + WS_LISTG), (int*)(ws + WS_TOKE), (int*)(ws + WS_TOKP)); } SEAM(6);
    if (IN(7)) {
        pg8::MoeOrder<true> S{(const char*)(ws + WS_H2), (const char*)(ws + WS_WGU), (const u32*)(ctl + CW_CNT), (const int*)(ws + WS_LIST), 1024, 8, 2048, F.G, F.vcu, 0};
        pg8::EpiMoeGlu E{(bf16_t*)(ws + WS_ACT), (const float*)args.in[19]};
        pg8::gemm_phase(F.lds, 1024, S, E);
    } SEAM(7);
    if (IN(8)) {
        pg8::MoeOrder<false> S{(const char*)(ws + WS_ACT), (const char*)(ws + WS_WDN), (const u32*)(ctl + CW_CNT), (const int*)(ws + WS_LIST), 1024, 4, 1024, F.G, F.vcu, 0};
        pg8::EpiMoeDown E{(bf16_t*)(ws + WS_YS), (const float*)args.in[21], (const float*)(ws + WS_LISTG)};
        pg8::gemm_phase(F.lds, 1024, S, E);
    } SEAM(8);
    if (IN(9)) { combine_phase(F.vcu * NWAVES + F.wave, F.G * NWAVES, F.lane, (const float*)(ws + WS_X1), (const bf16_t*)(ws + WS_YS), (const u32*)(ctl + CW_CNT), (const int*)(ws + WS_TOKE), (const int*)(ws + WS_TOKP), (const float*)args.in[22], args.out); }
#undef IN
#undef SEAM
}

static int g_grid = 0;
static void launch_mega(Args a, int lo, int hi, hipStream_t s) { a.ph_lo = lo; a.ph_hi = hi; hipLaunchKernelGGL(mega, dim3(g_grid), dim3(NTHR), LDS_BYTES, s, a); }
extern "C" void kernel_launch(void* const* d_in, const int* in_sizes, int n_in, void* d_out, int out_size, void* d_ws, size_t ws_size, hipStream_t stream) {
    if (n_in != 23 || in_sizes[0] != NTOK * DM || out_size != NTOK * DM || ws_size < WS_END) { fprintf(stderr, "kernel_launch: unexpected shapes (n_in %d, ws %zu)\n", n_in, ws_size); return; }
    if (g_grid == 0) {
        int dev = 0, cus = 0;
        if (hipGetDevice(&dev) != hipSuccess || hipDeviceGetAttribute(&cus, hipDeviceAttributeMultiprocessorCount, dev) != hipSuccess) { fprintf(stderr, "kernel_launch: device query failed\n"); g_grid = -1; return; }
        if (hipFuncSetAttribute((const void*)mega, hipFuncAttributeMaxDynamicSharedMemorySize, LDS_BYTES) != hipSuccess) { fprintf(stderr, "kernel_launch: hipFuncSetAttribute failed\n"); g_grid = -1; return; }
        (void)hipGetLastError();
        g_grid = cus;
    }
    if (g_grid < 0) return;
    const float* x = (const float*)d_in[0];
    const float* conv_w = (const float*)d_in[4]; const float* conv_b = (const float*)d_in[5]; const float* dt_bias = (const float*)d_in[6]; const float* a_log = (const float*)d_in[7];
    const float* d_skip = (const float*)d_in[8]; const float* ssd_norm_g = (const float*)d_in[9]; const float* q_norm_g = (const float*)d_in[10]; const float* w_uq = (const float*)d_in[11];
    const float* kv_norm_g = (const float*)d_in[12]; const float* w_ukv = (const float*)d_in[13]; const float* w_out = (const float*)d_in[14]; const float* norm_ffn_g = (const float*)d_in[15];
    const float* w_router = (const float*)d_in[16]; const float* b_router = (const float*)d_in[17]; const float* w_gate_up = (const float*)d_in[18]; const float* b_gate_up = (const float*)d_in[19];
    const float* w_down = (const float*)d_in[20]; const float* b_down = (const float*)d_in[21]; const float* norm_final_g = (const float*)d_in[22];
    char* ws = (char*)d_ws; float* out = (float*)d_out;
    u32* ctl = (u32*)(ws + WS_CTL); float* ropec = (float*)(ws + WS_ROPEC); float* ropes = (float*)(ws + WS_ROPES);
    bf16_t* PROJ = (bf16_t*)(ws + WS_PROJ); bf16_t* CQ = (bf16_t*)(ws + WS_CQ); bf16_t* CKV = (bf16_t*)(ws + WS_CKV);
    float* DT = (float*)(ws + WS_DT); float* PARTQ = (float*)(ws + WS_PARTQ); float* PARTKV = (float*)(ws + WS_PARTKV);
    bf16_t* Qb = (bf16_t*)(ws + WS_Q); bf16_t* Kb = (bf16_t*)(ws + WS_K); bf16_t* VTb = (bf16_t*)(ws + WS_VT);
    float* Y = (float*)(ws + WS_Y); bf16_t* YCAT = (bf16_t*)(ws + WS_YCAT); float* X1 = (float*)(ws + WS_X1); bf16_t* H2 = (bf16_t*)(ws + WS_H2);
    int* TOKE = (int*)(ws + WS_TOKE); int* TOKP = (int*)(ws + WS_TOKP); int* LIST = (int*)(ws + WS_LIST); float* LISTG = (float*)(ws + WS_LISTG);
    bf16_t* ACT = (bf16_t*)(ws + WS_ACT); bf16_t* YS = (bf16_t*)(ws + WS_YS); float* XBCC = (float*)(ws + WS_XBCC);
    Args a{}; for (int i = 0; i < 23; ++i) a.in[i] = d_in[i]; a.out = out; a.ws = (unsigned char*)d_ws;

    (void)hipMemsetAsync(ws + WS_CTL, 0, CTL_BYTES, stream);
    launch_mega(a, 0, 10, stream);
}
```

```cpp
#include <hip/hip_runtime.h>
#include <cstdio>
#include <cstdint>

typedef unsigned short bf16_t;
typedef unsigned u32;
typedef float f32x4 __attribute__((ext_vector_type(4)));
typedef unsigned u32x4 __attribute__((ext_vector_type(4)));
typedef unsigned u32x2 __attribute__((ext_vector_type(2)));
#define DI __device__ __forceinline__

constexpr int NB = 2, SEQ = 8192, DM = 1024, NTOK = NB * SEQ;
constexpr int IN_W = 1960;
constexpr int NH = 8, HP = 64, NG = 2, NST = 128, CHUNK = 128;
constexpr int QK = 96, NOPE = 64, ROPE = 32, VD = 64;
constexpr int NE = 32, TOPK = 4, DFF = 1024;
constexpr float EPS = 1e-6f;
constexpr float QSCALE = 0.14724444602590306f;
constexpr int SLOT_ROWS = NTOK * TOPK + NE * 256;

constexpr size_t MiB = 1u << 20;
constexpr size_t WS_CTL = 0, CTL_BYTES = 1 * MiB;
constexpr size_t WS_ROPEC = 1 * MiB, WS_ROPES = 2 * MiB;
constexpr size_t WS_H = 208 * MiB;
constexpr size_t WS_PROJ = 240 * MiB;
constexpr size_t WS_CQ = 288 * MiB;
constexpr size_t WS_CKV = 296 * MiB;
constexpr size_t WS_DT = 300 * MiB;
constexpr size_t WS_PARTQ = 301 * MiB;
constexpr size_t WS_PARTKV = 303 * MiB;
constexpr size_t WS_Q = 304 * MiB;
constexpr size_t WS_K = 328 * MiB;
constexpr size_t WS_VT = 352 * MiB;
constexpr size_t WS_Y = 368 * MiB;
constexpr size_t WS_STATES = 400 * MiB;
constexpr size_t WS_CD = 432 * MiB;
constexpr size_t WS_YCAT = 434 * MiB;
constexpr size_t WS_X1 = 466 * MiB;
constexpr size_t WS_H2 = 530 * MiB;
constexpr size_t WS_TOKE = 562 * MiB;
constexpr size_t WS_TOKP = WS_TOKE + 256 * 1024;
constexpr size_t WS_LIST = 563 * MiB;
constexpr size_t WS_LISTG = 565 * MiB;
constexpr size_t WS_ACT = 568 * MiB;
constexpr size_t WS_YS = 712 * MiB;
constexpr size_t WS_XBCC = 712 * MiB;
constexpr size_t WS_PREV = 856 * MiB;
constexpr size_t WS_END = 888 * MiB;
constexpr int CW_CNT = 64;

DI float bf2f(bf16_t v) { return __uint_as_float((u32)v << 16); }
DI u32 f2bf(float f) { u32 u = __float_as_uint(f); return (u + 0x7fffu + ((u >> 16) & 1u)) >> 16; }
DI u32 pk2(float lo, float hi) { return f2bf(lo) | (f2bf(hi) << 16); }
DI void store8(bf16_t* p, const float (&v)[8]) { u32x4 w; w.x = pk2(v[0], v[1]); w.y = pk2(v[2], v[3]); w.z = pk2(v[4], v[5]); w.w = pk2(v[6], v[7]); *(u32x4*)p = w; }
DI void load8(const bf16_t* p, float (&v)[8]) { const u32x4 w = *(const u32x4*)p;
    v[0] = __uint_as_float(w.x << 16); v[1] = __uint_as_float(w.x & 0xffff0000u); v[2] = __uint_as_float(w.y << 16); v[3] = __uint_as_float(w.y & 0xffff0000u);
    v[4] = __uint_as_float(w.z << 16); v[5] = __uint_as_float(w.z & 0xffff0000u); v[6] = __uint_as_float(w.w << 16); v[7] = __uint_as_float(w.w & 0xffff0000u); }
DI u32 pk4_fp8(float a, float b, float c, float d) { int w = __builtin_amdgcn_cvt_pk_fp8_f32(a, b, 0, false); w = __builtin_amdgcn_cvt_pk_fp8_f32(c, d, w, true); return (u32)w; }
constexpr float W8_SCALE = 32.f, W8_INV = 1.f / 32.f;
DI float wave_sum(float v) {
#pragma unroll
    for (int o = 1; o < 64; o <<= 1) v += __shfl_xor(v, o);
    return v;
}
DI float silu(float v) { return v / (1.f + __expf(-v)); }
DI size_t qk_off(int b, int h, int s, int dc) { return ((((size_t)(b * NH + h) * 128 + (s >> 6)) * 12 + dc) * 64 + (s & 63)) * 8; }
DI size_t vt_off(int b, int h, int s, int d) {
    const int sl = s & 63, g16 = sl >> 4, w = sl & 15, a = (w >> 3) & 1, bb = (w >> 2) & 1, c = w & 3;
    return ((((size_t)(b * NH + h) * 128 + (s >> 6)) * 8 + (2 * g16 + bb)) * 64 + d) * 8 + 4 * a + c;
}
__host__ __device__ inline int inproj_src_col(int c) {
    if (c < 1536) return c;
    if (c < 1792) return 1544 + (c - 1536);
    if (c < 1920) return 1800 + (c - 1792);
    if (c < 1952) { const int i = c - 1920; return 1928 + (i >> 1) + ((i & 1) ? 16 : 0); }
    if (c < 1960) return 1536 + (c - 1952);
    return -1;
}
__host__ __device__ inline int q_src_col(int c) { const int h = c / 96, r = c - h * 96; if (r < 64) return h * 96 + r; const int i = r - 64; return h * 96 + 64 + (i >> 1) + ((i & 1) ? 16 : 0); }

__device__ const double INVF2PI[16] = {0.15915494309189535, 0.08949940160889101, 0.050329212104487035, 0.0283021958306234, 0.015915494309189534, 0.0089499401608891, 0.005032921210448704, 0.00283021958306234,
                                      0.0015915494309189536, 0.0008949940160889102, 0.0005032921210448703, 0.00028302195830623395, 0.00015915494309189535, 8.9499401608891e-05, 5.0329212104487035e-05, 2.83021958306234e-05};

__global__ __launch_bounds__(256) void k_rope_table(const int* __restrict__ pos, float* __restrict__ rc, float* __restrict__ rs) {
    const int idx = blockIdx.x * 256 + threadIdx.x; if (idx >= NTOK * 16) return;
    const int tok = idx >> 4, i = idx & 15;
    double t = (double)pos[tok] * INVF2PI[i]; t -= floor(t);
    const float fr = (float)t;
    rc[idx] = __builtin_amdgcn_cosf(fr); rs[idx] = __builtin_amdgcn_sinf(fr);
}
__global__ __launch_bounds__(256) void k_rmsnorm_bf16(const float* __restrict__ x, const float* __restrict__ g, bf16_t* __restrict__ out) {
    const int row = blockIdx.x * 4 + (threadIdx.x >> 6), lane = threadIdx.x & 63;
    const f32x4* xr = (const f32x4*)(x + (size_t)row * DM) + lane; f32x4 v[4]; float ss = 0.f;
#pragma unroll
    for (int j = 0; j < 4; ++j) { v[j] = xr[64 * j]; ss += v[j].x * v[j].x + v[j].y * v[j].y + v[j].z * v[j].z + v[j].w * v[j].w; }
    const float r = rsqrtf(wave_sum(ss) * (1.f / DM) + EPS);
#pragma unroll
    for (int j = 0; j < 4; ++j) { const f32x4 gg = ((const f32x4*)g)[lane + 64 * j]; u32x2 w; w.x = pk2(v[j].x * r * gg.x, v[j].y * r * gg.y); w.y = pk2(v[j].z * r * gg.z, v[j].w * r * gg.w);
        *(u32x2*)(out + (size_t)row * DM + 4 * (lane + 64 * j)) = w; }
}

struct EpiInproj {
    bf16_t* proj; bf16_t* cq; bf16_t* ckv; float* dt; bf16_t* kbuf; const float* ropec; const float* ropes;
    DI float rowctx(int) const { return 1.f; }
    DI void operator()(int row, int col0, const float (&v)[8], float) const {
        if (col0 < 1536) { store8(proj + (size_t)row * 1536 + col0, v); }
        else if (col0 < 1792) { store8(cq + (size_t)row * 256 + (col0 - 1536), v); }
        else if (col0 < 1920) { store8(ckv + (size_t)row * 128 + (col0 - 1792), v); }
        else if (col0 < 1952) { const int i0 = (col0 - 1920) >> 1; float o[8];
#pragma unroll
            for (int m = 0; m < 4; ++m) { const float c = ropec[(size_t)row * 16 + i0 + m], s = ropes[(size_t)row * 16 + i0 + m]; o[2 * m] = v[2 * m] * c - v[2 * m + 1] * s; o[2 * m + 1] = v[2 * m + 1] * c + v[2 * m] * s; }
            const int b = row >> 13, s_ = row & (SEQ - 1), dc = 8 + ((col0 - 1920) >> 3);
#pragma unroll
            for (int h = 0; h < NH; ++h) store8(kbuf + qk_off(b, h, s_, dc), o); }
        else if (col0 == 1952) { *(f32x4*)(dt + (size_t)row * 8) = (f32x4){v[0], v[1], v[2], v[3]}; *(f32x4*)(dt + (size_t)row * 8 + 4) = (f32x4){v[4], v[5], v[6], v[7]}; }
    }
};
DI float part_sum(const float* p, int n4) { float s = 0.f; for (int i = 0; i < n4; ++i) { const f32x4 t = ((const f32x4*)p)[i]; s += (t.x + t.y) + (t.z + t.w); } return s; }
struct EpiQ {
    bf16_t* q; const float* partq; const float* ropec; const float* ropes;
    DI float rowctx(int row) const { return partq[row] * QSCALE; }
    DI void operator()(int row, int col0, const float (&v)[8], float rs) const {
        const int h = col0 / 96, c = col0 - h * 96; float o[8];
        if (c < 64) {
#pragma unroll
            for (int j = 0; j < 8; ++j) o[j] = v[j] * rs;
        } else { const int i0 = (c - 64) >> 1;
#pragma unroll
            for (int m = 0; m < 4; ++m) { const float cc = ropec[(size_t)row * 16 + i0 + m], ss = ropes[(size_t)row * 16 + i0 + m]; const float a = v[2 * m] * rs, b = v[2 * m + 1] * rs; o[2 * m] = a * cc - b * ss; o[2 * m + 1] = b * cc + a * ss; } }
        store8(q + qk_off(row >> 13, h, row & (SEQ - 1), c >> 3), o);
    }
};
struct EpiKn {
    bf16_t* k; const float* partkv;
    DI float rowctx(int row) const { return partkv[row]; }
    DI void operator()(int row, int col0, const float (&v)[8], float rs) const {
        const int h = col0 >> 6, c = col0 & 63; float o[8];
#pragma unroll
        for (int j = 0; j < 8; ++j) o[j] = v[j] * rs;
        store8(k + qk_off(row >> 13, h, row & (SEQ - 1), c >> 3), o);
    }
};
struct EpiVt {
    bf16_t* vt; const float* partkv;
    DI float rowctx(int) const { return 1.f; }
    DI void operator()(int row, int tok0, const float (&v)[8], float) const {
        const int h = row >> 6, d = row & 63; float o[8];
#pragma unroll
        for (int j = 0; j < 8; ++j) o[j] = v[j] * partkv[tok0 + j];
        const size_t o0 = vt_off(tok0 >> 13, h, tok0 & (SEQ - 1), d), o1 = vt_off(tok0 >> 13, h, (tok0 & (SEQ - 1)) + 4, d);
        u32x2 w0, w1; w0.x = pk2(o[0], o[1]); w0.y = pk2(o[2], o[3]); w1.x = pk2(o[4], o[5]); w1.y = pk2(o[6], o[7]);
        *(u32x2*)(vt + o0) = w0; *(u32x2*)(vt + o1) = w1;
    }
};
struct EpiOut {
    const float* x; float* x1;
    DI float rowctx(int) const { return 1.f; }
    DI void operator()(int row, int col0, const float (&v)[8], float) const {
        const f32x4 a = *(const f32x4*)(x + (size_t)row * DM + col0), b = *(const f32x4*)(x + (size_t)row * DM + col0 + 4);
        *(f32x4*)(x1 + (size_t)row * DM + col0) = (f32x4){a.x + v[0], a.y + v[1], a.z + v[2], a.w + v[3]};
        *(f32x4*)(x1 + (size_t)row * DM + col0 + 4) = (f32x4){b.x + v[4], b.y + v[5], b.z + v[6], b.w + v[7]};
    }
};
struct EpiGlu {
    unsigned char* act; const float* bgu; int e, base;
    DI void operator()(int r, int f0, const float (&g)[8], const float (&u)[8]) const {
        float o[8];
#pragma unroll
        for (int j = 0; j < 8; ++j) { float gg = g[j] * W8_INV + bgu[(size_t)e * 2048 + f0 + j], uu = u[j] * W8_INV + bgu[(size_t)e * 2048 + 1024 + f0 + j];
            gg = fminf(gg, 7.f); uu = fminf(fmaxf(uu, -7.f), 7.f); const float glu = gg / (1.f + __expf(-1.702f * gg)); o[j] = (uu + 1.f) * glu; }
        u32x2 w; w.x = pk4_fp8(o[0], o[1], o[2], o[3]); w.y = pk4_fp8(o[4], o[5], o[6], o[7]); *(u32x2*)(act + (size_t)(base + r) * DFF + f0) = w;
    }
};
struct EpiDown {
    bf16_t* ys; const float* bd; const float* listg; int e, base, cnt;
    DI void operator()(int r, int c0, const float (&v)[8]) const {
        const float gw = r < cnt ? listg[(size_t)e * NTOK + r] : 0.f; float o[8];
#pragma unroll
        for (int j = 0; j < 8; ++j) o[j] = (v[j] * W8_INV + bd[(size_t)e * DM + c0 + j]) * gw;
        store8(ys + (size_t)(base + r) * DM + c0, o);
    }
};

template <class AF, class BF, class EF>
__global__ __launch_bounds__(256) void naive_gemm(int K, AF af, BF bf, EF ef) {
    __shared__ float As[16][68]; __shared__ float Bs[16][132];
    const int tid = threadIdx.x, ty = tid >> 4, tx = tid & 15, row0 = blockIdx.y * 64, col0 = blockIdx.x * 128;
    float acc[4][8];
#pragma unroll
    for (int i = 0; i < 4; ++i)
#pragma unroll
        for (int j = 0; j < 8; ++j) acc[i][j] = 0.f;
    for (int k0 = 0; k0 < K; k0 += 16) {
#pragma unroll
        for (int i = 0; i < 4; ++i) { const int idx = tid + i * 256, m = idx >> 4, k = idx & 15; As[k][m] = af(row0 + m, k0 + k); }
#pragma unroll
        for (int i = 0; i < 8; ++i) { const int idx = tid + i * 256, k = idx >> 7, n = idx & 127; Bs[k][n] = bf(k0 + k, col0 + n); }
        __syncthreads();
#pragma unroll
        for (int k = 0; k < 16; ++k) { float a[4], b[8];
#pragma unroll
            for (int i = 0; i < 4; ++i) a[i] = As[k][ty * 4 + i];
#pragma unroll
            for (int j = 0; j < 8; ++j) b[j] = Bs[k][tx * 8 + j];
#pragma unroll
            for (int i = 0; i < 4; ++i)
#pragma unroll
                for (int j = 0; j < 8; ++j) acc[i][j] += a[i] * b[j]; }
        __syncthreads();
    }
#pragma unroll
    for (int i = 0; i < 4; ++i) { const int row = row0 + ty * 4 + i; ef(row, col0 + tx * 8, acc[i], ef.rowctx(row)); }
}
struct ABf16 { const bf16_t* p; int ld; int pad; DI float operator()(int m, int k) const { return bf2f(p[(size_t)m * ld + k]); } };
struct BInproj { const float* w; DI float operator()(int k, int n) const { const int s = inproj_src_col(n); return s >= 0 ? w[(size_t)k * IN_W + s] : 0.f; } };
struct BUq { const float* w; const float* g; DI float operator()(int k, int n) const { return g[k] * w[(size_t)k * 768 + q_src_col(n)]; } };
struct BKn { const float* w; const float* g; DI float operator()(int k, int n) const { return g[k] * w[(size_t)k * 1024 + (n >> 6) * 128 + (n & 63)]; } };
struct AVw { const float* w; const float* g; DI float operator()(int m, int k) const { return g[k] * w[(size_t)k * 1024 + (m >> 6) * 128 + 64 + (m & 63)]; } };
struct BTok { const bf16_t* p; int ld; int pad; DI float operator()(int k, int n) const { return bf2f(p[(size_t)n * ld + k]); } };
struct BPlain { const float* w; int ld; int pad; DI float operator()(int k, int n) const { return w[(size_t)k * ld + n]; } };

__global__ __launch_bounds__(256) void naive_conv(const bf16_t* __restrict__ proj, const float* __restrict__ cw, const float* __restrict__ cb, float* __restrict__ xc) {
    const size_t idx = (size_t)blockIdx.x * 256 + threadIdx.x; const int tok = (int)(idx >> 10), ch = (int)(idx & 1023), t = tok & (SEQ - 1);
    float a = cb[ch];
#pragma unroll
    for (int k = 0; k < 4; ++k) { const int tt = t + k - 3; if (tt >= 0) a += cw[k * 1024 + ch] * bf2f(proj[(size_t)(tok + k - 3) * 1536 + 512 + ch]); }
    xc[idx] = silu(a);
}
__global__ __launch_bounds__(256) void naive_ssd(const float* __restrict__ xc, const float* __restrict__ dtr, const float* __restrict__ dt_bias, const float* __restrict__ a_log, const float* __restrict__ d_skip, float* __restrict__ y) {
    const int b = blockIdx.x >> 3, h = blockIdx.x & 7, g = h >> 2, p = threadIdx.x >> 2, nq = threadIdx.x & 3;
    const float a = -__expf(a_log[h]), dsk = d_skip[h], dtb = dt_bias[h];
    float st[32];
#pragma unroll
    for (int i = 0; i < 32; ++i) st[i] = 0.f;
    for (int t = 0; t < SEQ; ++t) {
        const size_t tok = (size_t)b * SEQ + t; const float* row = xc + tok * 1024;
        const float v = dtr[tok * 8 + h] + dtb; const float dtv = v > 20.f ? v : log1pf(__expf(v));
        const float dA = __expf(dtv * a), xv = row[h * 64 + p], xd = dtv * xv;
        const f32x4* Bp = (const f32x4*)(row + 512 + g * 128 + nq * 32); const f32x4* Cp = (const f32x4*)(row + 768 + g * 128 + nq * 32);
        float yy = 0.f;
#pragma unroll
        for (int i = 0; i < 8; ++i) { const f32x4 bv = Bp[i], cv = Cp[i];
            st[4 * i + 0] = st[4 * i + 0] * dA + xd * bv.x; yy += cv.x * st[4 * i + 0];
            st[4 * i + 1] = st[4 * i + 1] * dA + xd * bv.y; yy += cv.y * st[4 * i + 1];
            st[4 * i + 2] = st[4 * i + 2] * dA + xd * bv.z; yy += cv.z * st[4 * i + 2];
            st[4 * i + 3] = st[4 * i + 3] * dA + xd * bv.w; yy += cv.w * st[4 * i + 3]; }
        yy += __shfl_xor(yy, 1); yy += __shfl_xor(yy, 2);
        if (nq == 0) y[tok * 512 + h * 64 + p] = yy + dsk * xv;
    }
}
__global__ __launch_bounds__(256) void k_ssd_gate_norm(const float* __restrict__ y, const bf16_t* __restrict__ proj, const float* __restrict__ ng, bf16_t* __restrict__ ycat) {
    const int w = blockIdx.x * 4 + (threadIdx.x >> 6), lane = threadIdx.x & 63, tok = w >> 1, g = w & 1, c0 = g * 256 + 4 * lane;
    const f32x4 yv = *(const f32x4*)(y + (size_t)tok * 512 + c0); const u32x2 zz = *(const u32x2*)(proj + (size_t)tok * 1536 + c0);
    const float z0 = __uint_as_float(zz.x << 16), z1 = __uint_as_float(zz.x & 0xffff0000u), z2 = __uint_as_float(zz.y << 16), z3 = __uint_as_float(zz.y & 0xffff0000u);
    const float v0 = yv.x * silu(z0), v1 = yv.y * silu(z1), v2 = yv.z * silu(z2), v3 = yv.w * silu(z3);
    const float r = rsqrtf(wave_sum(v0 * v0 + v1 * v1 + v2 * v2 + v3 * v3) * (1.f / 256.f) + EPS);
    const f32x4 gg = *(const f32x4*)(ng + c0); u32x2 o; o.x = pk2(v0 * r * gg.x, v1 * r * gg.y); o.y = pk2(v2 * r * gg.z, v3 * r * gg.w);
    *(u32x2*)(ycat + (size_t)tok * DM + c0) = o;
}

__global__ __launch_bounds__(64) void naive_attn(const bf16_t* __restrict__ Q, const bf16_t* __restrict__ K, const bf16_t* __restrict__ VT, bf16_t* __restrict__ ycat) {
    const int bh = blockIdx.x >> 7, qblk = blockIdx.x & 127, b = bh >> 3, h = bh & 7, qi = qblk * 64 + threadIdx.x;
    float q[96], o[64];
#pragma unroll
    for (int dc = 0; dc < 12; ++dc) { float t[8]; load8(Q + qk_off(b, h, qi, dc), t);
#pragma unroll
        for (int j = 0; j < 8; ++j) q[dc * 8 + j] = t[j]; }
#pragma unroll
    for (int d = 0; d < 64; ++d) o[d] = 0.f;
    float m = -1e30f, l = 0.f;
    const int kmax = qblk * 64 + 63;
    for (int key = 0; key <= kmax; ++key) {
        float s = 0.f;
#pragma unroll
        for (int dc = 0; dc < 12; ++dc) { float t[8]; load8(K + qk_off(b, h, key, dc), t);
#pragma unroll
            for (int j = 0; j < 8; ++j) s += q[dc * 8 + j] * t[j]; }
        if (key <= qi) {
            const float mn = fmaxf(m, s), al = exp2f(m - mn), pp = exp2f(s - mn);
            l = l * al + pp; m = mn;
#pragma unroll
            for (int d = 0; d < 64; ++d) o[d] = o[d] * al + pp * bf2f(VT[vt_off(b, h, key, d)]);
        }
    }
    const float il = 1.f / l; const size_t tok = (size_t)b * SEQ + qi;
#pragma unroll
    for (int d = 0; d < 64; d += 8) { float t[8];
#pragma unroll
        for (int j = 0; j < 8; ++j) t[j] = o[d + j] * il;
        store8(ycat + tok * DM + 512 + h * 64 + d, t); }
}

__global__ __launch_bounds__(256) void k_router(const float* __restrict__ x1, const float* __restrict__ g, const float* __restrict__ wr, const float* __restrict__ br, bf16_t* __restrict__ h2,
                                                u32* __restrict__ cnt, int* __restrict__ list, float* __restrict__ listg, int* __restrict__ toke, int* __restrict__ tokp) {
    const int tok = blockIdx.x * 4 + (threadIdx.x >> 6), lane = threadIdx.x & 63;
    const f32x4* xr = (const f32x4*)(x1 + (size_t)tok * DM) + lane; f32x4 v[4]; float ss = 0.f;
#pragma unroll
    for (int j = 0; j < 4; ++j) { v[j] = xr[64 * j]; ss += v[j].x * v[j].x + v[j].y * v[j].y + v[j].z * v[j].z + v[j].w * v[j].w; }
    const float r = rsqrtf(wave_sum(ss) * (1.f / DM) + EPS);
    float lg[32];
#pragma unroll
    for (int e = 0; e < 32; ++e) lg[e] = 0.f;
#pragma unroll
    for (int j = 0; j < 4; ++j) { const f32x4 gg = ((const f32x4*)g)[lane + 64 * j]; const float hv[4] = {v[j].x * r * gg.x, v[j].y * r * gg.y, v[j].z * r * gg.z, v[j].w * r * gg.w};
        u32x2 w; w.x = pk2(hv[0], hv[1]); w.y = pk2(hv[2], hv[3]); *(u32x2*)(h2 + (size_t)tok * DM + 4 * (lane + 64 * j)) = w;
#pragma unroll
        for (int i = 0; i < 4; ++i) { const f32x4* wp = (const f32x4*)(wr + (size_t)(4 * (lane + 64 * j) + i) * NE);
#pragma unroll
            for (int e4 = 0; e4 < 8; ++e4) { const f32x4 ww = wp[e4]; lg[4 * e4] += hv[i] * ww.x; lg[4 * e4 + 1] += hv[i] * ww.y; lg[4 * e4 + 2] += hv[i] * ww.z; lg[4 * e4 + 3] += hv[i] * ww.w; } } }
#pragma unroll
    for (int e = 0; e < 32; ++e) lg[e] = wave_sum(lg[e]) + br[e];
    int sel[4]; float sv[4];
#pragma unroll
    for (int k = 0; k < 4; ++k) { float best = -3.0e38f; int bi = 0;
#pragma unroll
        for (int e = 0; e < 32; ++e) if (lg[e] > best) { best = lg[e]; bi = e; }
        sel[k] = bi; sv[k] = best;
#pragma unroll
        for (int e = 0; e < 32; ++e) if (e == bi) lg[e] = -3.0e38f; }
    const float e1 = __expf(sv[1] - sv[0]), e2 = __expf(sv[2] - sv[0]), e3 = __expf(sv[3] - sv[0]), inv = 1.f / (1.f + e1 + e2 + e3);
    const float gw[4] = {inv, e1 * inv, e2 * inv, e3 * inv};
    if (lane == 0) {
#pragma unroll
        for (int k = 0; k < 4; ++k) { const int e = sel[k]; const u32 p = atomicAdd(cnt + e, 1u); list[(size_t)e * NTOK + p] = tok; listg[(size_t)e * NTOK + p] = gw[k]; toke[tok * 4 + k] = e; tokp[tok * 4 + k] = (int)p; }
    }
}
__global__ __launch_bounds__(256) void k_combine(const float* __restrict__ x1, const bf16_t* __restrict__ ys, const u32* __restrict__ cnt, const int* __restrict__ toke, const int* __restrict__ tokp, const float* __restrict__ g, float* __restrict__ out) {
    const int tok = blockIdx.x * 4 + (threadIdx.x >> 6), lane = threadIdx.x & 63;
    int tiles = lane < 32 ? (int)((cnt[lane & 31] + 255) >> 8) : 0, incl = tiles;
#pragma unroll
    for (int o = 1; o < 32; o <<= 1) { const int t = __shfl_up(incl, o); if ((lane & 31) >= o) incl += t; }
    const int excl = (incl - tiles) << 8;
    f32x4 v[4];
#pragma unroll
    for (int j = 0; j < 4; ++j) v[j] = ((const f32x4*)(x1 + (size_t)tok * DM))[lane + 64 * j];
#pragma unroll
    for (int k = 0; k < 4; ++k) { const int e = toke[tok * 4 + k], p = tokp[tok * 4 + k]; const int srow = __shfl(excl, e) + p; const bf16_t* yr = ys + (size_t)srow * DM;
#pragma unroll
        for (int j = 0; j < 4; ++j) { const u32x2 w = *(const u32x2*)(yr + 4 * (lane + 64 * j));
            v[j].x += __uint_as_float(w.x << 16); v[j].y += __uint_as_float(w.x & 0xffff0000u); v[j].z += __uint_as_float(w.y << 16); v[j].w += __uint_as_float(w.y & 0xffff0000u); } }
    float ss = 0.f;
#pragma unroll
    for (int j = 0; j < 4; ++j) ss += v[j].x * v[j].x + v[j].y * v[j].y + v[j].z * v[j].z + v[j].w * v[j].w;
    const float r = rsqrtf(wave_sum(ss) * (1.f / DM) + EPS);
#pragma unroll
    for (int j = 0; j < 4; ++j) { const f32x4 gg = ((const f32x4*)g)[lane + 64 * j]; ((f32x4*)(out + (size_t)tok * DM))[lane + 64 * j] = (f32x4){v[j].x * r * gg.x, v[j].y * r * gg.y, v[j].z * r * gg.z, v[j].w * r * gg.w}; }
}


#define LAS __attribute__((address_space(3)))
#define GAS __attribute__((address_space(1)))
typedef short bf16x8 __attribute__((ext_vector_type(8)));
typedef int i32x4_t __attribute__((ext_vector_type(4)));
typedef int i32x8_t __attribute__((ext_vector_type(8)));
typedef GAS unsigned gu32;
#define RLX_AGENT __ATOMIC_RELAXED, __HIP_MEMORY_SCOPE_AGENT
namespace pg8 {
__device__ __forceinline__ const char* uni(const char* p) { const unsigned long long u = (unsigned long long)p; const unsigned lo = __builtin_amdgcn_readfirstlane((unsigned)u), hi = __builtin_amdgcn_readfirstlane((unsigned)(u >> 32));
    return (const char*)(((unsigned long long)hi << 32) | lo); }
constexpr int BM = 256, BK = 64, HALF = 128, HTB = HALF * BK * 2  , STAGE_BYTES = 8 * HTB;
__host__ __device__ __forceinline__ int lds_byte(int r, int c) { const int st = (r >> 4) * 2 + (c >> 5), rr = r & 15, cc = c & 31, ob = rr * 64 + cc * 2; return st * 1024 + (ob ^ (((ob >> 9) & 1) << 5)); }
__host__ __device__ __forceinline__ void stage_rc(int b, int& R, int& C) { const int st = b / 1024, sb = b % 1024, swz = sb ^ (((sb >> 9) & 1) << 5); R = (st >> 1) * 16 + swz / 64; C = (st & 1) * 32 + (swz % 64) / 2; }
__host__ __device__ __forceinline__ int perm32(int rho) { const int n = rho >> 4, i = rho & 15; return 8 * (i >> 2) + 4 * n + (i & 3); }

struct Unit { int pm, pn; const char* A; const char* B; int e, base, cnt, pad; };

template <bool FP8 = false, class Epi, class Sched>
__device__ __forceinline__ void gemm_phase(LAS unsigned char* lds, const int K_, const Sched& S, const Epi& E) {
    int K = K_; asm volatile("" : "+s"(K));
    const int tid = threadIdx.x, wid = __builtin_amdgcn_readfirstlane(tid >> 6), lane = tid & 63, wr = wid >> 2, wc = wid & 3, fr = lane & 15, fq = lane >> 4;
    const int nt = K / BK;
    int RA[2], CA[2]; unsigned voffB[2];
#pragma unroll
    for (int i = 0; i < 2; ++i) { int R, C; stage_rc(tid * 16 + i * 8192, R, C); const int Rb = (R & ~31) + perm32(R & 31); RA[i] = R; CA[i] = C; voffB[i] = (unsigned)(Rb * K + C) * 2u; }
    const size_t kstep = (size_t)(BK * 2);
    const size_t hstepB = (size_t)HALF * K * 2;
    const unsigned ldsw = (unsigned)wid * 1024u;
    const int aoff = lds_byte(wr * 64 + fr, fq * 8), boff = lds_byte(wc * 32 + fr, fq * 8);
#define PG8_SA(b, h) (((b) * 2 + (h)) * HTB)
#define PG8_SB(b, h) ((4 + (b) * 2 + (h)) * HTB)
#define PG8_STAGE(bufoff, gbase, v0, v1) do { \
        __builtin_amdgcn_global_load_lds((const unsigned*)((const char*)(gbase) + (v0)), (LAS unsigned*)(lds + (bufoff) + ldsw), 16, 0, 0); \
        __builtin_amdgcn_global_load_lds((const unsigned*)((const char*)(gbase) + (v1)), (LAS unsigned*)(lds + (bufoff) + ldsw + 8192), 16, 0, 0); } while (0)
#define PG8_STAGEB(bufoff, gbase) PG8_STAGE(bufoff, gbase, voffB[0], voffB[1])
#define PG8_LD8(p) __builtin_shufflevector(*(const LAS i32x4_t*)(p), *(const LAS i32x4_t*)((p) + 1024), 0, 1, 2, 3, 4, 5, 6, 7)
#define PG8_LDA(dst, b, h) do { if constexpr (FP8) { _Pragma("unroll") for (int m = 0; m < 4; ++m) dst##8[m] = PG8_LD8(lds + PG8_SA(b, h) + aoff + m * 2048); } \
        else { _Pragma("unroll") for (int m = 0; m < 4; ++m) _Pragma("unroll") for (int k = 0; k < 2; ++k) dst[m][k] = *(const LAS bf16x8*)(lds + PG8_SA(b, h) + aoff + m * 2048 + k * 1024); } } while (0)
#define PG8_LDB(dst, b, h) do { if constexpr (FP8) { _Pragma("unroll") for (int n = 0; n < 2; ++n) dst##8[n] = PG8_LD8(lds + PG8_SB(b, h) + boff + n * 2048); } \
        else { _Pragma("unroll") for (int n = 0; n < 2; ++n) _Pragma("unroll") for (int k = 0; k < 2; ++k) dst[n][k] = *(const LAS bf16x8*)(lds + PG8_SB(b, h) + boff + n * 2048 + k * 1024); } } while (0)
#define PG8_MMA(ai, bj, At, Bt) do { __builtin_amdgcn_s_setprio(1); if constexpr (FP8) { _Pragma("unroll") for (int m = 0; m < 4; ++m) _Pragma("unroll") for (int n = 0; n < 2; ++n) \
        acc[ai][bj][m][n] = __builtin_amdgcn_mfma_scale_f32_16x16x128_f8f6f4(Bt##8[n], At##8[m], acc[ai][bj][m][n], 0, 0, 0, 0x7f7f7f7f, 0, 0x7f7f7f7f); } \
      else { _Pragma("unroll") for (int m = 0; m < 4; ++m) _Pragma("unroll") for (int n = 0; n < 2; ++n) _Pragma("unroll") for (int k = 0; k < 2; ++k) \
        acc[ai][bj][m][n] = __builtin_amdgcn_mfma_f32_16x16x32_bf16(Bt[n][k], At[m][k], acc[ai][bj][m][n], 0, 0, 0); } __builtin_amdgcn_s_setprio(0); } while (0)
#define PG8_WAIT_V(n) asm volatile("s_waitcnt vmcnt(" #n ")" ::: "memory")
#define PG8_WAIT_L(n) asm volatile("s_waitcnt lgkmcnt(" #n ")" ::: "memory")
#define PG8_BAR __builtin_amdgcn_s_barrier()
#define PG8_SCHED __builtin_amdgcn_sched_barrier(0)
    Unit cur, nxt; int ui = 0;
    if (!S.next(0, cur)) return;
    f32x4 acc[2][2][4][2];
#pragma unroll
    for (int a = 0; a < 2; ++a)
#pragma unroll
        for (int b = 0; b < 2; ++b)
#pragma unroll
            for (int m = 0; m < 4; ++m)
#pragma unroll
                for (int n = 0; n < 2; ++n) acc[a][b][m][n] = (f32x4){0.f, 0.f, 0.f, 0.f};
    bf16x8 At[4][2], B0[2][2], B1[2][2]; i32x8_t At8[4], B08[2], B18[2];
    unsigned vc[2][2], vn[2][2];
#pragma unroll
    for (int h = 0; h < 2; ++h)
#pragma unroll
        for (int i = 0; i < 2; ++i) { vc[h][i] = S.arow(cur, RA[i] + h * HALF) + (unsigned)CA[i] * 2u; vn[h][i] = vc[h][i]; }
    const char* cA = cur.A; const char* cB = cur.B;
    PG8_STAGEB(PG8_SB(0, 0), cB); PG8_STAGEB(PG8_SB(0, 1), cB + hstepB); PG8_STAGE(PG8_SA(0, 0), cA, vc[0][0], vc[0][1]); PG8_STAGE(PG8_SA(0, 1), cA, vc[1][0], vc[1][1]);
    if (wr == 1) PG8_BAR;
    PG8_WAIT_V(2); PG8_BAR;
    PG8_STAGEB(PG8_SB(1, 0), cB + kstep); PG8_STAGE(PG8_SA(1, 0), cA + kstep, vc[0][0], vc[0][1]); PG8_STAGEB(PG8_SB(1, 1), cB + hstepB + kstep);
    PG8_WAIT_V(6); PG8_BAR;
#pragma unroll 1
    for (;;) {
        const bool has_next = S.next(ui + 1, nxt);
        const char* nA = has_next ? nxt.A : cA; const char* nB = has_next ? nxt.B : cB;
        if (Sched::GATHER) { if (has_next) {
#pragma unroll
            for (int h = 0; h < 2; ++h)
#pragma unroll
                for (int i = 0; i < 2; ++i) vn[h][i] = S.arow(nxt, RA[i] + h * HALF) + (unsigned)CA[i] * 2u; } }
#pragma unroll 1
        for (int t = 0; t < nt; t += 2) {
            const bool last = (t == nt - 2);
            const char* a1 = uni(cA + (size_t)(t + 1) * kstep);
            const char* a2 = uni(last ? nA : cA + (size_t)(t + 2) * kstep); const char* b2 = uni(last ? nB : cB + (size_t)(t + 2) * kstep);
            const char* a3 = a2 + kstep; const char* b3 = b2 + kstep;
            unsigned v2[2][2];
#pragma unroll
            for (int h = 0; h < 2; ++h)
#pragma unroll
                for (int i = 0; i < 2; ++i) v2[h][i] = (Sched::GATHER && last) ? vn[h][i] : vc[h][i];
            PG8_LDB(B0, 0, 0); PG8_LDB(B1, 0, 1); PG8_SCHED; PG8_LDA(At, 0, 0); PG8_STAGE(PG8_SA(1, 1), a1, vc[1][0], vc[1][1]);
            PG8_WAIT_V(8); PG8_WAIT_L(0); PG8_BAR; PG8_MMA(0, 0, At, B0); PG8_MMA(0, 1, At, B1); PG8_BAR; PG8_SCHED;
            PG8_LDA(At, 0, 1); PG8_STAGEB(PG8_SB(0, 0), b2); PG8_STAGEB(PG8_SB(0, 1), b2 + hstepB); PG8_STAGE(PG8_SA(0, 0), a2, v2[0][0], v2[0][1]);
            PG8_WAIT_V(8); PG8_WAIT_L(0); PG8_BAR; PG8_MMA(1, 0, At, B0); PG8_MMA(1, 1, At, B1); PG8_BAR; PG8_SCHED;
            PG8_LDB(B0, 1, 0); PG8_LDB(B1, 1, 1); PG8_SCHED; PG8_LDA(At, 1, 0); PG8_STAGE(PG8_SA(0, 1), a2, v2[1][0], v2[1][1]);
            PG8_WAIT_V(8); PG8_WAIT_L(0); PG8_BAR; PG8_MMA(0, 0, At, B0); PG8_MMA(0, 1, At, B1); PG8_BAR; PG8_SCHED;
            PG8_LDA(At, 1, 1); PG8_STAGEB(PG8_SB(1, 0), b3); PG8_STAGEB(PG8_SB(1, 1), b3 + hstepB); PG8_STAGE(PG8_SA(1, 0), a3, v2[0][0], v2[0][1]);
            PG8_WAIT_V(8); PG8_WAIT_L(0); PG8_BAR; PG8_MMA(1, 0, At, B0); PG8_MMA(1, 1, At, B1); PG8_BAR; PG8_SCHED;
        }
        if (wr == 0) PG8_BAR;
        E(acc, cur, wr, wc, fr, fq);
        if (!has_next) break;
#pragma unroll
        for (int a = 0; a < 2; ++a)
#pragma unroll
            for (int b = 0; b < 2; ++b)
#pragma unroll
                for (int m = 0; m < 4; ++m)
#pragma unroll
                    for (int n = 0; n < 2; ++n) acc[a][b][m][n] = (f32x4){0.f, 0.f, 0.f, 0.f};
        cur = nxt; cA = nA; cB = nB; ++ui;
#pragma unroll
        for (int h = 0; h < 2; ++h)
#pragma unroll
            for (int i = 0; i < 2; ++i) vc[h][i] = vn[h][i];
        if (wr == 1) PG8_BAR;
    }
    PG8_WAIT_V(0);
    PG8_BAR;
#undef PG8_SA
#undef PG8_SB
#undef PG8_STAGE
#undef PG8_STAGEB
#undef PG8_LDA
#undef PG8_LDB
#undef PG8_MMA
#undef PG8_LD8
#undef PG8_WAIT_V
#undef PG8_WAIT_L
#undef PG8_BAR
#undef PG8_SCHED
}

template <class EF> struct EpiRows {
    EF ef;
    __device__ __forceinline__ void operator()(const f32x4 (&acc)[2][2][4][2], const Unit& u, int wr, int wc, int fr, int fq) const {
        const int row0 = u.pm * BM + wr * 64 + fr, col0 = u.pn * BM + wc * 32 + 8 * fq;
#pragma unroll
        for (int ai = 0; ai < 2; ++ai)
#pragma unroll
            for (int m = 0; m < 4; ++m) { const int row = row0 + ai * HALF + m * 16; const float ctx = ef.rowctx(row);
#pragma unroll
                for (int bj = 0; bj < 2; ++bj) { const f32x4 a = acc[ai][bj][m][0], b = acc[ai][bj][m][1]; const float v[8] = {a[0], a[1], a[2], a[3], b[0], b[1], b[2], b[3]}; ef(row, col0 + bj * HALF, v, ctx); } }
    }
};
struct GridOrder {
    const char* A; const char* Bt; int K, nM, nN, G, vcu, pad;
    static constexpr bool GATHER = false;
    __device__ __forceinline__ bool next(int i, Unit& u) const { const int L = i * G + vcu; if (L >= nM * nN) return false; u.pm = L / nN; u.pn = L - u.pm * nN;
        u.A = A + (size_t)u.pm * BM * K * 2; u.B = Bt + (size_t)u.pn * BM * K * 2; u.e = 0; u.base = 0; u.cnt = 0; u.pad = 0; return true; }
    __device__ __forceinline__ unsigned arow(const Unit&, int R) const { return (unsigned)(R * K) * 2u; }
};
}

#define XB_TMO      128
#define XB_XCNT(j)  (256  + 64 * (j))
#define XB_XSUB(j)  (1280 + 64 * (j))
#define XB_XGEN(j)  (2304 + 64 * (j))
#define XB_TOP      3328
#define XB_TOPGEN   3392
#define XCD_BAR_WORDS 3456
#define XB_SPIN_CAP (1u << 18)
__device__ __forceinline__ unsigned xb_ld(unsigned* p)              { return __hip_atomic_load(p, __ATOMIC_RELAXED, __HIP_MEMORY_SCOPE_AGENT); }
__device__ __forceinline__ unsigned xb_add(unsigned* p, unsigned v) { return __hip_atomic_fetch_add(p, v, __ATOMIC_RELAXED, __HIP_MEMORY_SCOPE_AGENT); }
__device__ __forceinline__ unsigned xb_xcc_id() { return (unsigned)__builtin_amdgcn_s_getreg((3 << 11) | 20) & 0xFu; }
#define XB_SPIN(cond, bar) do { unsigned _sp = 0; while (cond) { __builtin_amdgcn_s_sleep(1); \
    if ((++_sp & 255u) == 0u) { if (xb_ld(&(bar)[XB_TMO])) break; if (_sp > XB_SPIN_CAP) { atomicAdd(&(bar)[XB_TMO], 1u); break; } } } } while (0)
struct XcdBarrier { unsigned* bar; unsigned x; volatile LAS unsigned* st; };
__device__ __forceinline__ XcdBarrier xcd_barrier_post(unsigned* bar, volatile LAS unsigned* st) {
    XcdBarrier b; b.bar = bar; b.x = xb_xcc_id(); b.st = st;
    if (threadIdx.x == 0) (void)xb_add(&bar[XB_XCNT(b.x)], 1u);
    return b;
}
__device__ __forceinline__ void xcd_barrier_complete(unsigned* bar, unsigned x, unsigned& nloc, unsigned& nx) {
    const unsigned G = gridDim.x * gridDim.y * gridDim.z;
    unsigned sum, cnt, mine, sp = 0u;
    for (;;) {
        sum = 0u; cnt = 0u; mine = 0u;
#pragma unroll
        for (unsigned j = 0; j < 16; ++j) { const unsigned c = xb_ld(&bar[XB_XCNT(j)]); sum += c; cnt += (c > 0u) ? 1u : 0u; mine = (j == x) ? c : mine; }
        if (sum == G) break;
        __builtin_amdgcn_s_sleep(1);
        if ((++sp & 255u) == 0u) { if (xb_ld(&bar[XB_TMO])) break; if (sp > XB_SPIN_CAP) { atomicAdd(&bar[XB_TMO], 1u); break; } }
    }
    nloc = mine > 0u ? mine : 1u; nx = cnt > 0u ? cnt : 1u;
}
__device__ __forceinline__ void xcd_barrier(const XcdBarrier& b) {
    asm volatile("s_waitcnt vmcnt(0)" ::: "memory");
    __syncthreads();
    if (threadIdx.x == 0) {
        unsigned* bar = b.bar;
        __builtin_amdgcn_s_waitcnt(0);
        unsigned nloc = b.st[0], nx = b.st[1];
        if (nloc == 0u) { xcd_barrier_complete(bar, b.x, nloc, nx); b.st[0] = nloc; b.st[1] = nx; }
        const unsigned old = xb_add(&bar[XB_XSUB(b.x)], 1u);
        const unsigned gen = old / nloc;
        if (old + 1u == (gen + 1u) * nloc) {
            __builtin_amdgcn_fence(__ATOMIC_RELEASE, "agent");
            asm volatile("s_waitcnt vmcnt(0)" ::: "memory");
            const unsigned og = xb_add(&bar[XB_TOP], 1u);
            const unsigned tg = og / nx;
            if (og + 1u == (tg + 1u) * nx) xb_add(&bar[XB_TOPGEN], 1u);
            else XB_SPIN(xb_ld(&bar[XB_TOPGEN]) == tg, bar);
            __builtin_amdgcn_fence(__ATOMIC_ACQUIRE, "agent");
            xb_add(&bar[XB_XGEN(b.x)], 1u);
            asm volatile("s_waitcnt vmcnt(0)" ::: "memory");
        } else {
            XB_SPIN(xb_ld(&bar[XB_XGEN(b.x)]) == gen, bar);
            __builtin_amdgcn_fence(__ATOMIC_ACQUIRE, "agent");
            asm volatile("s_waitcnt vmcnt(0)" ::: "memory");
        }
    }
    __syncthreads();
}

constexpr int NWAVES = 8, NTHR = 512;
constexpr int RING_BYTES = 131072, LDSCTL_OFF = RING_BYTES, MISC_OFF = LDSCTL_OFF + 320, LDS_BYTES = 147456;
constexpr int CW_BAR = 4096;
constexpr size_t WS_WIN = 4 * MiB, WS_WUQ = 8 * MiB, WS_WKN = 9 * MiB, WS_WV = 9 * MiB + 512 * 1024, WS_WOUT = 10 * MiB, WS_WGU = 16 * MiB, WS_WDN = 144 * MiB;

struct Args { const void* in[23]; float* out; unsigned char* ws; int ph_lo, ph_hi; };

template <class SrcMap>
__device__ __forceinline__ void p0_tile(const float* __restrict__ W, int ldw, int K, const float* __restrict__ gk, bf16_t* __restrict__ WT, int k0, int n0, const SrcMap& sm, int lane) {
    const int src = sm(n0 + lane);
    float v[64];
    if (src >= 0) {
#pragma unroll
        for (int i = 0; i < 64; ++i) v[i] = W[(size_t)(k0 + i) * ldw + src];
        if (gk) {
#pragma unroll
            for (int i = 0; i < 64; ++i) v[i] *= gk[k0 + i];
        }
    } else {
#pragma unroll
        for (int i = 0; i < 64; ++i) v[i] = 0.f;
    }
    bf16_t* o = WT + (size_t)(n0 + lane) * K + k0;
#pragma unroll
    for (int i = 0; i < 8; ++i) { u32x4 w; w.x = pk2(v[8 * i], v[8 * i + 1]); w.y = pk2(v[8 * i + 2], v[8 * i + 3]); w.z = pk2(v[8 * i + 4], v[8 * i + 5]); w.w = pk2(v[8 * i + 6], v[8 * i + 7]); *(u32x4*)(o + 8 * i) = w; }
}
template <class SrcMap>
__device__ __forceinline__ void p0_tile8(const float* __restrict__ W, int ldw, int K, unsigned char* __restrict__ WT, int k0, int n0, const SrcMap& sm, int lane) {
    const int src = sm(n0 + lane);
    float v[64];
#pragma unroll
    for (int i = 0; i < 64; ++i) v[i] = W[(size_t)(k0 + i) * ldw + src] * W8_SCALE;
    unsigned char* o = WT + (size_t)(n0 + lane) * K + k0;
#pragma unroll
    for (int i = 0; i < 4; ++i) { u32x4 w; w.x = pk4_fp8(v[16 * i], v[16 * i + 1], v[16 * i + 2], v[16 * i + 3]); w.y = pk4_fp8(v[16 * i + 4], v[16 * i + 5], v[16 * i + 6], v[16 * i + 7]);
        w.z = pk4_fp8(v[16 * i + 8], v[16 * i + 9], v[16 * i + 10], v[16 * i + 11]); w.w = pk4_fp8(v[16 * i + 12], v[16 * i + 13], v[16 * i + 14], v[16 * i + 15]); *(u32x4*)(o + 16 * i) = w; }
}
struct MapIn { __device__ __forceinline__ int operator()(int c) const { return inproj_src_col(c); } };
struct MapQ { __device__ __forceinline__ int operator()(int c) const { return q_src_col(c); } };
struct MapKn { __device__ __forceinline__ int operator()(int c) const { return (c >> 6) * 128 + (c & 63); } };
struct MapV { __device__ __forceinline__ int operator()(int c) const { return (c >> 6) * 128 + 64 + (c & 63); } };
struct MapId { __device__ __forceinline__ int operator()(int c) const { return c; } };
struct MapGU { __device__ __forceinline__ int operator()(int c) const { const int t = c >> 8, r = c & 255; return r < 128 ? 128 * t + r : 1024 + 128 * t + (r - 128); } };

namespace pg8 {
struct EpiColsVt {
    bf16_t* vt; const float* partkv;
    __device__ __forceinline__ void operator()(const f32x4 (&acc)[2][2][4][2], const Unit& u, int wr, int wc, int fr, int fq) const {
        const int row0 = u.pm * BM + wr * 64 + fr, col0 = u.pn * BM + wc * 32 + 8 * fq;
#pragma unroll
        for (int bj = 0; bj < 2; ++bj) {
            const int tok0 = col0 + bj * HALF, b = tok0 >> 13, s = tok0 & (SEQ - 1), sl = s & 63;
            const unsigned tbase = (unsigned)(((b * NH * 128 + (s >> 6)) * 8 + 2 * (sl >> 4)) * 512 + 4 * ((sl >> 3) & 1));
            const f32x4 s0 = *(const f32x4*)(partkv + tok0), s1 = *(const f32x4*)(partkv + tok0 + 4);
#pragma unroll
            for (int ai = 0; ai < 2; ++ai)
#pragma unroll
                for (int m = 0; m < 4; ++m) { const int row = row0 + ai * HALF + m * 16, h = row >> 6, d = row & 63;
                    const f32x4 a = acc[ai][bj][m][0], bb = acc[ai][bj][m][1]; const unsigned o0 = tbase + (unsigned)h * 524288u + (unsigned)d * 8u;
                    u32x2 w0, w1; w0.x = pk2(a[0] * s0[0], a[1] * s0[1]); w0.y = pk2(a[2] * s0[2], a[3] * s0[3]); w1.x = pk2(bb[0] * s1[0], bb[1] * s1[1]); w1.y = pk2(bb[2] * s1[2], bb[3] * s1[3]);
                    *(u32x2*)(vt + o0) = w0; *(u32x2*)(vt + o0 + 512) = w1; }
            asm volatile("" ::: "memory");
        }
    }
};
struct EpiMoeGlu {
    unsigned char* act; const float* bgu;
    __device__ __forceinline__ void operator()(const f32x4 (&acc)[2][2][4][2], const Unit& u, int wr, int wc, int fr, int fq) const {
        const EpiGlu E{act, bgu, u.e, u.base}; const int r0 = u.pm * BM + wr * 64 + fr, f0 = u.pn * HALF + wc * 32 + 8 * fq;
#pragma unroll
        for (int ai = 0; ai < 2; ++ai)
#pragma unroll
            for (int m = 0; m < 4; ++m) { const f32x4 g0 = acc[ai][0][m][0], g1 = acc[ai][0][m][1], u0 = acc[ai][1][m][0], u1 = acc[ai][1][m][1];
                const float g[8] = {g0[0], g0[1], g0[2], g0[3], g1[0], g1[1], g1[2], g1[3]}, uu[8] = {u0[0], u0[1], u0[2], u0[3], u1[0], u1[1], u1[2], u1[3]};
                E(r0 + ai * HALF + m * 16, f0, g, uu); }
    }
};
struct EpiMoeDown {
    bf16_t* ys; const float* bd; const float* listg;
    __device__ __forceinline__ void operator()(const f32x4 (&acc)[2][2][4][2], const Unit& u, int wr, int wc, int fr, int fq) const {
        const EpiDown E{ys, bd, listg, u.e, u.base, u.cnt}; const int r0 = u.pm * BM + wr * 64 + fr, c0 = u.pn * BM + wc * 32 + 8 * fq;
#pragma unroll
        for (int ai = 0; ai < 2; ++ai)
#pragma unroll
            for (int m = 0; m < 4; ++m)
#pragma unroll
                for (int bj = 0; bj < 2; ++bj) { const f32x4 a = acc[ai][bj][m][0], b = acc[ai][bj][m][1]; const float v[8] = {a[0], a[1], a[2], a[3], b[0], b[1], b[2], b[3]}; E(r0 + ai * HALF + m * 16, c0 + bj * HALF, v); }
    }
};
struct EpiInprojMfma {
    EpiInproj ef; float* scaleq; float* scalekv; LAS float* P;
    __device__ __forceinline__ void operator()(const f32x4 (&acc)[2][2][4][2], const Unit& u, int wr, int wc, int fr, int fq) const {
        const int row0 = u.pm * BM + wr * 64 + fr, col0 = u.pn * BM + wc * 32 + 8 * fq;
#pragma unroll
        for (int ai = 0; ai < 2; ++ai)
#pragma unroll
            for (int m = 0; m < 4; ++m) { const int row = row0 + ai * HALF + m * 16;
#pragma unroll
                for (int bj = 0; bj < 2; ++bj) { const f32x4 a = acc[ai][bj][m][0], b = acc[ai][bj][m][1]; const float v[8] = {a[0], a[1], a[2], a[3], b[0], b[1], b[2], b[3]}; ef(row, col0 + bj * HALF, v, 1.f); } }
        if (u.pn >= 6) {
            const bool isq = (u.pn == 6);
#pragma unroll
            for (int ai = 0; ai < 2; ++ai)
#pragma unroll
                for (int m = 0; m < 4; ++m) { float s = 0.f;
#pragma unroll
                    for (int n = 0; n < 2; ++n) { const f32x4 x = acc[ai][0][m][n]; s += (x[0] * x[0] + x[1] * x[1]) + (x[2] * x[2] + x[3] * x[3]); }
                    if (isq) {
#pragma unroll
                        for (int n = 0; n < 2; ++n) { const f32x4 x = acc[ai][1][m][n]; s += (x[0] * x[0] + x[1] * x[1]) + (x[2] * x[2] + x[3] * x[3]); } }
                    s += __shfl_xor(s, 16); s += __shfl_xor(s, 32);
                    if (fq == 0) P[(ai * HALF + wr * 64 + m * 16 + fr) * 4 + wc] = s; }
            asm volatile("s_waitcnt lgkmcnt(0)" ::: "memory"); __builtin_amdgcn_s_barrier(); asm volatile("" ::: "memory");
            const int t = threadIdx.x;
            if (t < 256) { const f32x4 p = *(const LAS f32x4*)(P + t * 4); const float sum = (p[0] + p[1]) + (p[2] + p[3]);
                if (isq) scaleq[u.pm * BM + t] = rsqrtf(sum * (1.f / 256.f) + EPS); else scalekv[u.pm * BM + t] = rsqrtf(sum * (1.f / 128.f) + EPS); }
            asm volatile("s_waitcnt lgkmcnt(0)" ::: "memory"); __builtin_amdgcn_s_barrier(); asm volatile("" ::: "memory");
        }
    }
};
struct GridOrderRot {
    const char* A; const char* Bt; int K, nM, nN, G, vcu, rot;
    static constexpr bool GATHER = false;
    __device__ __forceinline__ bool next(int i, Unit& u) const { int w = vcu - rot; if (w < 0) w += G; const int L = i * G + w; if (L >= nM * nN) return false; u.pm = L / nN; u.pn = L - u.pm * nN;
        u.A = A + (size_t)u.pm * BM * K * 2; u.B = Bt + (size_t)u.pn * BM * K * 2; u.e = 0; u.base = 0; u.cnt = 0; u.pad = 0; return true; }
    __device__ __forceinline__ unsigned arow(const Unit&, int R) const { return (unsigned)(R * K) * 2u; }
};
template <bool GATH> struct MoeOrder {
    const char* A; const char* Bt; const u32* cnt; const int* list; int K, nN, nfull, G, vcu, pad;
    static constexpr bool GATHER = GATH;
    __device__ __forceinline__ bool next(int i, Unit& u) const {
        const int L = i * G + vcu, mt = L / nN; int acc = 0, e = 0, c = 0;
        for (; e < NE; ++e) { c = (int)cnt[e * 64]; const int t = (c + 255) >> 8; if (mt < acc + t) break; acc += t; }
        if (e >= NE) return false;
        u.e = e; u.base = acc << 8; u.cnt = c; u.pm = mt - acc; u.pn = L - mt * nN; u.pad = 0;
        u.A = GATH ? A : A + (size_t)(u.base + u.pm * BM) * K * 2; u.B = Bt + ((size_t)e * nfull + (size_t)u.pn * BM) * K * 2; return true;
    }
    __device__ __forceinline__ unsigned arow(const Unit& u, int R) const {
        if (!GATH) return (unsigned)(R * K) * 2u;
        const int r = u.pm * BM + R; const int tok = list[(size_t)u.e * NTOK + (r < u.cnt ? r : 0)]; return (unsigned)tok * (unsigned)K * 2u;
    }
};
}

namespace g8 {
using pg8::lds_byte; using pg8::stage_rc; using pg8::perm32; using pg8::Unit; using pg8::uni;
constexpr int BUF = 49152, OFF_B = 16384, HTB = 16384;
template <class Epi, class Sched>
__device__ __forceinline__ void gemm_phase(LAS unsigned char* lds, const int KB_, const Sched& S, const Epi& E) {
    int KB = KB_; asm volatile("" : "+s"(KB));
    const int tid = threadIdx.x, wid = __builtin_amdgcn_readfirstlane(tid >> 6), lane = tid & 63, wr = wid >> 2, wc = wid & 3, fr = lane & 15, fq = lane >> 4;
    const int nt = KB / 128;
    int RA[2], CA[2]; unsigned voffB[2];
#pragma unroll
    for (int i = 0; i < 2; ++i) { int R, C; stage_rc(tid * 16 + i * 8192, R, C); const int Rb = (R & ~31) + perm32(R & 31); RA[i] = R; CA[i] = C * 2; voffB[i] = (unsigned)(Rb * KB + C * 2); }
    const unsigned ldsw = (unsigned)wid * 1024u; const size_t hstepB = (size_t)128 * KB;
    const int aoff = lds_byte(wr * 64 + fr, fq * 8), boff = lds_byte(wc * 32 + fr, fq * 8);
#define G8_GLDS(dst, src) __builtin_amdgcn_global_load_lds((const unsigned*)(src), (LAS unsigned*)(lds + (dst)), 16, 0, 0)
#define G8_STAGE(bsel, a, va0, va1, bb, kt) do { const char* a_ = uni((a) + (size_t)(kt) * 128); const char* b_ = uni((bb) + (size_t)(kt) * 128); \
        G8_GLDS((bsel) * BUF + ldsw, a_ + (va0)); G8_GLDS((bsel) * BUF + ldsw + 8192, a_ + (va1)); \
        G8_GLDS((bsel) * BUF + OFF_B + ldsw, b_ + voffB[0]); G8_GLDS((bsel) * BUF + OFF_B + ldsw + 8192, b_ + voffB[1]); \
        G8_GLDS((bsel) * BUF + OFF_B + HTB + ldsw, b_ + hstepB + voffB[0]); G8_GLDS((bsel) * BUF + OFF_B + HTB + ldsw + 8192, b_ + hstepB + voffB[1]); } while (0)
#define G8_LD8(p) __builtin_shufflevector(*(const LAS i32x4_t*)(p), *(const LAS i32x4_t*)((p) + 1024), 0, 1, 2, 3, 4, 5, 6, 7)
    Unit cur, nxt; int ui = 0;
    if (!S.next(0, cur)) return;
    f32x4 acc[2][4][2];
#pragma unroll
    for (int b = 0; b < 2; ++b)
#pragma unroll
        for (int m = 0; m < 4; ++m)
#pragma unroll
            for (int n = 0; n < 2; ++n) acc[b][m][n] = (f32x4){0.f, 0.f, 0.f, 0.f};
    unsigned vc[2], vn[2];
#pragma unroll
    for (int i = 0; i < 2; ++i) { vc[i] = S.arow(cur, RA[i]) + (unsigned)CA[i]; vn[i] = vc[i]; }
    G8_STAGE(0, cur.A, vc[0], vc[1], cur.B, 0); G8_STAGE(1, cur.A, vc[0], vc[1], cur.B, 1);
    asm volatile("s_waitcnt vmcnt(6)" ::: "memory"); __builtin_amdgcn_s_barrier(); asm volatile("" ::: "memory");
    int bsel = 0;
#pragma unroll 1
    for (;;) {
        const bool has_next = S.next(ui + 1, nxt);
        if (Sched::GATHER) { if (has_next) {
#pragma unroll
            for (int i = 0; i < 2; ++i) vn[i] = S.arow(nxt, RA[i]) + (unsigned)CA[i]; } }
#pragma unroll 1
        for (int t = 0; t < nt; ++t) {
            i32x8_t A8[4], B8[2][2];
#pragma unroll
            for (int n = 0; n < 2; ++n) { B8[0][n] = G8_LD8(lds + bsel * BUF + OFF_B + boff + n * 2048); B8[1][n] = G8_LD8(lds + bsel * BUF + OFF_B + HTB + boff + n * 2048); }
#pragma unroll
            for (int m = 0; m < 4; ++m) A8[m] = G8_LD8(lds + bsel * BUF + aoff + m * 2048);
            asm volatile("s_waitcnt lgkmcnt(0)" ::: "memory"); __builtin_amdgcn_s_barrier(); asm volatile("" ::: "memory");
            __builtin_amdgcn_sched_barrier(0);
            if (t + 2 < nt) G8_STAGE(bsel, cur.A, vc[0], vc[1], cur.B, t + 2);
            else if (has_next) G8_STAGE(bsel, nxt.A, vn[0], vn[1], nxt.B, t + 2 - nt);
            else G8_STAGE(bsel, cur.A, vc[0], vc[1], cur.B, t + 2 - nt);
            __builtin_amdgcn_sched_barrier(0);
            __builtin_amdgcn_s_setprio(1);
#pragma unroll
            for (int b = 0; b < 2; ++b)
#pragma unroll
                for (int m = 0; m < 4; ++m)
#pragma unroll
                    for (int n = 0; n < 2; ++n) acc[b][m][n] = __builtin_amdgcn_mfma_scale_f32_16x16x128_f8f6f4(B8[b][n], A8[m], acc[b][m][n], 0, 0, 0, 0x7f7f7f7f, 0, 0x7f7f7f7f);
            __builtin_amdgcn_s_setprio(0);
            __builtin_amdgcn_sched_barrier(0);
            asm volatile("s_waitcnt vmcnt(6)" ::: "memory"); __builtin_amdgcn_s_barrier(); asm volatile("" ::: "memory");
            bsel ^= 1;
        }
        E(acc, cur, wr, wc, fr, fq);
        if (!has_next) break;
#pragma unroll
        for (int b = 0; b < 2; ++b)
#pragma unroll
            for (int m = 0; m < 4; ++m)
#pragma unroll
                for (int n = 0; n < 2; ++n) acc[b][m][n] = (f32x4){0.f, 0.f, 0.f, 0.f};
        cur = nxt; ++ui; vc[0] = vn[0]; vc[1] = vn[1];
    }
    asm volatile("s_waitcnt vmcnt(0)" ::: "memory"); __builtin_amdgcn_s_barrier(); asm volatile("" ::: "memory");
#undef G8_GLDS
#undef G8_STAGE
#undef G8_LD8
}
struct EpiMoeGlu {
    unsigned char* act; const float* bgu;
    __device__ __forceinline__ void operator()(const f32x4 (&acc)[2][4][2], const Unit& u, int wr, int wc, int fr, int fq) const {
        const EpiGlu E{act, bgu, u.e, u.base}; const int r0 = u.pm * 128 + wr * 64 + fr, f0 = u.pn * 128 + wc * 32 + 8 * fq;
#pragma unroll
        for (int m = 0; m < 4; ++m) { const f32x4 g0 = acc[0][m][0], g1 = acc[0][m][1], u0 = acc[1][m][0], u1 = acc[1][m][1];
            const float g[8] = {g0[0], g0[1], g0[2], g0[3], g1[0], g1[1], g1[2], g1[3]}, uu[8] = {u0[0], u0[1], u0[2], u0[3], u1[0], u1[1], u1[2], u1[3]};
            E(r0 + m * 16, f0, g, uu); }
    }
};
struct EpiMoeDown {
    bf16_t* ys; const float* bd; const float* listg;
    __device__ __forceinline__ void operator()(const f32x4 (&acc)[2][4][2], const Unit& u, int wr, int wc, int fr, int fq) const {
        const EpiDown E{ys, bd, listg, u.e, u.base, u.cnt}; const int r0 = u.pm * 128 + wr * 64 + fr, c0 = u.pn * 256 + wc * 32 + 8 * fq;
#pragma unroll
        for (int m = 0; m < 4; ++m)
#pragma unroll
            for (int bj = 0; bj < 2; ++bj) { const f32x4 a = acc[bj][m][0], b = acc[bj][m][1]; const float v[8] = {a[0], a[1], a[2], a[3], b[0], b[1], b[2], b[3]}; E(r0 + m * 16, c0 + bj * 128, v); }
    }
};
template <bool GATH> struct MoeOrder {
    const char* A; const char* Bt; const u32* cnt; const int* list; int KB, nN, nfull, G, vcu, pad;
    static constexpr bool GATHER = GATH;
    __device__ __forceinline__ bool next(int i, Unit& u) const {
        const int L = i * G + vcu, mt = L / nN; int acc = 0, e = 0, c = 0;
        for (; e < NE; ++e) { c = (int)cnt[e * 64]; const int t = (c + 127) >> 7; if (mt < acc + t) break; acc += t; }
        if (e >= NE) return false;
        u.e = e; u.base = acc << 7; u.cnt = c; u.pm = mt - acc; u.pn = L - mt * nN; u.pad = 0;
        u.A = GATH ? A : A + (size_t)(u.base + u.pm * 128) * KB; u.B = Bt + ((size_t)e * nfull + (size_t)u.pn * 256) * KB; return true;
    }
    __device__ __forceinline__ unsigned arow(const Unit& u, int R) const {
        if (!GATH) return (unsigned)(R * KB);
        const int r = u.pm * 128 + R; const int tok = list[(size_t)u.e * NTOK + (r < u.cnt ? r : 0)]; return (unsigned)tok * (unsigned)KB;
    }
};
}

namespace att {
typedef float f32x16 __attribute__((ext_vector_type(16)));
typedef float f32x2_t __attribute__((ext_vector_type(2))); typedef __bf16 bf16x2_t __attribute__((ext_vector_type(2)));
__device__ __forceinline__ unsigned cvtpk(float lo, float hi) { f32x2_t v = {lo, hi}; bf16x2_t b = __builtin_convertvector(v, bf16x2_t); return __builtin_bit_cast(unsigned, b); }
__device__ __forceinline__ int crow(int r, int hi) { return (r & 3) + 8 * (r >> 2) + 4 * hi; }
constexpr int KTB = 12288, VTB = 8192, BUFB = KTB + VTB;
constexpr int NBUF = 4, LDS_NEED = NBUF * BUFB;
#define ATT_MFMA(a, b, c) __builtin_amdgcn_mfma_f32_32x32x16_bf16((a), (b), (c), 0, 0, 0)

__device__ __forceinline__ void attn_unit(LAS unsigned char* lds, int b, int h, int qb, const bf16_t* __restrict__ Q, const bf16_t* __restrict__ K, const bf16_t* __restrict__ VT, bf16_t* __restrict__ ycat) {
    const int tid = threadIdx.x, lane = tid & 63, r32 = lane & 31, hi = lane >> 5, w = __builtin_amdgcn_readfirstlane(tid >> 6);
    const int q0 = qb * 256 + w * 32;
    bf16x8 qf[6];
#pragma unroll
    for (int s = 0; s < 6; ++s) qf[s] = *(const bf16x8*)(Q + qk_off(b, h, q0 + r32, 2 * s + hi));
    const int NT = 4 * (qb + 1), tlast = 4 * qb + (w >> 1);
    const char* kbase = (const char*)K + (size_t)((b * NH + h) * 128) * KTB;
    const char* vbase = (const char*)VT + (size_t)((b * NH + h) * 128) * VTB;
#define ATT_ISSUE(t, bsel) do { _Pragma("unroll") for (int j_ = 0; j_ < 3; ++j_) { const int i_ = w + 8 * j_; if (i_ < 20) { \
        const char* src_ = (i_ < 12) ? kbase + (size_t)(t) * KTB + i_ * 1024 : vbase + (size_t)(t) * VTB + (i_ - 12) * 1024; \
        __builtin_amdgcn_global_load_lds((const unsigned*)(src_ + lane * 16), (LAS unsigned*)(lds + (bsel) * BUFB + i_ * 1024), 16, 0, 0); } } } while (0)
    f32x16 o0, o1, negm;
#pragma unroll
    for (int r = 0; r < 16; ++r) { o0[r] = 0.f; o1[r] = 0.f; negm[r] = 0.f; }
    float l_run = 0.f;
    const bool lag = (w >= 4);
    u32x4 pw[4];
#pragma unroll
    for (int i = 0; i < 4; ++i) pw[i] = (u32x4){0u, 0u, 0u, 0u};
#define ATT_PV() do { _Pragma("unroll") for (int s_ = 0; s_ < 4; ++s_) { const bf16x8 pf_ = __builtin_bit_cast(bf16x8, pw[s_]); o0 = ATT_MFMA(vf[2 * s_], pf_, o0); o1 = ATT_MFMA(vf[2 * s_ + 1], pf_, o1); } } while (0)
    ATT_ISSUE(0, 0); ATT_ISSUE(1, 1);
#pragma unroll 1
    for (int t = 0; t < NT; ++t) {
        if (t + 1 < NT) { if (w < 4) asm volatile("s_waitcnt vmcnt(3)" ::: "memory"); else asm volatile("s_waitcnt vmcnt(2)" ::: "memory"); }
        else asm volatile("s_waitcnt vmcnt(0)" ::: "memory");
        __builtin_amdgcn_s_barrier(); asm volatile("" ::: "memory");
        const int vt = lag ? t - 1 : t; const bool do_pv = (vt >= 0) && (vt <= tlast), do_qk = (t <= tlast);
        const LAS unsigned char* vp = lds + (vt & 3) * BUFB + KTB + (hi * 64 + r32) * 16; const LAS unsigned char* kp = lds + (t & 3) * BUFB + (hi * 64 + r32) * 16;
        bf16x8 vf[8], kf[12];
#pragma unroll
        for (int s = 0; s < 4; ++s) { vf[2 * s] = *(const LAS bf16x8*)(vp + s * 2048); vf[2 * s + 1] = *(const LAS bf16x8*)(vp + s * 2048 + 512); }
#pragma unroll
        for (int s = 0; s < 6; ++s) { kf[2 * s] = *(const LAS bf16x8*)(kp + s * 2048); kf[2 * s + 1] = *(const LAS bf16x8*)(kp + s * 2048 + 512); }
        asm volatile("s_waitcnt lgkmcnt(0)" ::: "memory");
        __builtin_amdgcn_sched_barrier(0);
        if (t + 2 < NT) ATT_ISSUE(t + 2, (t + 2) & 3);
        __builtin_amdgcn_sched_barrier(0);
        if (lag && do_pv) ATT_PV();
        if (do_qk) {
            f32x16 p0 = ATT_MFMA(kf[0], qf[0], negm), p1 = ATT_MFMA(kf[1], qf[0], negm);
#pragma unroll
            for (int s = 1; s < 6; ++s) { p0 = ATT_MFMA(kf[2 * s], qf[s], p0); p1 = ATT_MFMA(kf[2 * s + 1], qf[s], p1); }
            if (t == tlast) { const int qg = q0 + r32, kg = 64 * t + 4 * hi;
#pragma unroll
                for (int r = 0; r < 16; ++r) { const int key = kg + (r & 3) + 8 * (r >> 2); if (key > qg) p0[r] = -INFINITY; if (key + 32 > qg) p1[r] = -INFINITY; } }
            float mx = fmaxf(p0[0], p1[0]);
#pragma unroll
            for (int r = 1; r < 16; ++r) mx = fmaxf(mx, fmaxf(p0[r], p1[r]));
            mx = fmaxf(mx, __shfl_xor(mx, 32));
            if (t == 0 || __any(mx > 0.f)) {
                const float dl = (t == 0) ? mx : fmaxf(mx, 0.f), alpha = __builtin_amdgcn_exp2f(-dl); l_run *= alpha;
#pragma unroll
                for (int r = 0; r < 16; ++r) { o0[r] *= alpha; o1[r] *= alpha; negm[r] -= dl; p0[r] -= dl; p1[r] -= dl; }
            }
            float rs = 0.f;
#pragma unroll
            for (int r = 0; r < 16; ++r) { p0[r] = __builtin_amdgcn_exp2f(p0[r]); p1[r] = __builtin_amdgcn_exp2f(p1[r]); rs += p0[r] + p1[r]; }
            l_run += rs;
#pragma unroll
            for (int i = 0; i < 4; ++i) { pw[0][i] = cvtpk(p0[2 * i], p0[2 * i + 1]); pw[1][i] = cvtpk(p0[8 + 2 * i], p0[9 + 2 * i]); pw[2][i] = cvtpk(p1[2 * i], p1[2 * i + 1]); pw[3][i] = cvtpk(p1[8 + 2 * i], p1[9 + 2 * i]); }
        }
        if (!lag && do_pv) ATT_PV();
    }
    if (lag && tlast == NT - 1) {
        const LAS unsigned char* vp = lds + ((NT - 1) & 3) * BUFB + KTB + (hi * 64 + r32) * 16; bf16x8 vf[8];
#pragma unroll
        for (int s = 0; s < 4; ++s) { vf[2 * s] = *(const LAS bf16x8*)(vp + s * 2048); vf[2 * s + 1] = *(const LAS bf16x8*)(vp + s * 2048 + 512); }
        ATT_PV();
    }
#undef ATT_PV
    const float l_tot = l_run + __shfl_xor(l_run, 32), inv = 1.f / l_tot;
    bf16_t* orow = ycat + (size_t)(b * SEQ + q0 + r32) * DM + 512 + h * 64 + 4 * hi;
#pragma unroll
    for (int g = 0; g < 4; ++g) {
        u32x2 a, c; a.x = cvtpk(o0[4 * g] * inv, o0[4 * g + 1] * inv); a.y = cvtpk(o0[4 * g + 2] * inv, o0[4 * g + 3] * inv);
        c.x = cvtpk(o1[4 * g] * inv, o1[4 * g + 1] * inv); c.y = cvtpk(o1[4 * g + 2] * inv, o1[4 * g + 3] * inv);
        *(u32x2*)(orow + 8 * g) = a; *(u32x2*)(orow + 32 + 8 * g) = c;
    }
    asm volatile("s_waitcnt lgkmcnt(0)" ::: "memory"); __builtin_amdgcn_s_barrier(); asm volatile("" ::: "memory");
#undef ATT_ISSUE
}
__device__ __forceinline__ void attn_phase(LAS unsigned char* lds, int vcu, int G, const bf16_t* Q, const bf16_t* K, const bf16_t* VT, bf16_t* ycat) {
    for (int idx = vcu; idx < NB * NH * 16; idx += G) { const int bh = idx >> 4, s = idx & 15;
        attn_unit(lds, bh >> 3, bh & 7, 31 - s, Q, K, VT, ycat);
        attn_unit(lds, bh >> 3, bh & 7, s, Q, K, VT, ycat); }
}
}

namespace ssd {
using att::f32x16; using att::cvtpk;
constexpr int PITCH = 272;
constexpr int L_CM = 0, L_BM = 34816, L_BWT = 69632, L_XT = 104448, L_SDT = 121856, L_SACUM = L_SDT + 512, L_END = L_SACUM + 512;
constexpr int F_CM = 0, F_SAC = 34816, F_TMP = F_SAC + 2048, F_PART = F_TMP + 2048, F_END = F_PART + 4096;
#define SSD_MFMA(a, b, c) __builtin_amdgcn_mfma_f32_32x32x16_bf16((a), (b), (c), 0, 0, 0)
__device__ __forceinline__ int qpos(int s) { return (s & ~12) | ((s & 4) << 1) | ((s & 8) >> 1); }
__device__ __forceinline__ float softplus(float v) { return v > 20.f ? v : log1pf(__expf(v)); }
__device__ __forceinline__ int crow(int r, int hi) { return (r & 3) + 8 * (r >> 2) + 4 * hi; }

__device__ __forceinline__ void conv_item(const bf16_t* __restrict__ proj, const float* __restrict__ cw, const float* __restrict__ cb, int b, int c, int ch0, int l0, float (&out)[4][8]) {
    float w[4][8], bias[8];
#pragma unroll
    for (int k = 0; k < 4; ++k) { const f32x4 w0 = *(const f32x4*)(cw + k * 1024 + ch0), w1 = *(const f32x4*)(cw + k * 1024 + ch0 + 4); w[k][0] = w0[0]; w[k][1] = w0[1]; w[k][2] = w0[2]; w[k][3] = w0[3]; w[k][4] = w1[0]; w[k][5] = w1[1]; w[k][6] = w1[2]; w[k][7] = w1[3]; }
    { const f32x4 b0 = *(const f32x4*)(cb + ch0), b1 = *(const f32x4*)(cb + ch0 + 4); bias[0] = b0[0]; bias[1] = b0[1]; bias[2] = b0[2]; bias[3] = b0[3]; bias[4] = b1[0]; bias[5] = b1[1]; bias[6] = b1[2]; bias[7] = b1[3]; }
#pragma unroll
    for (int i = 0; i < 4; ++i)
#pragma unroll
        for (int j = 0; j < 8; ++j) out[i][j] = bias[j];
    const int t0 = c * CHUNK + l0;
#pragma unroll
    for (int rr = 0; rr < 7; ++rr) {
        const int t = t0 - 3 + rr; float in[8];
        if (t >= 0) load8(proj + (size_t)(b * SEQ + t) * 1536 + 512 + ch0, in);
        else {
#pragma unroll
            for (int j = 0; j < 8; ++j) in[j] = 0.f; }
#pragma unroll
        for (int k = 0; k < 4; ++k) { const int i = rr - k; if (i >= 0 && i < 4) {
#pragma unroll
            for (int j = 0; j < 8; ++j) out[i][j] += w[k][j] * in[j]; } }
    }
#pragma unroll
    for (int i = 0; i < 4; ++i)
#pragma unroll
        for (int j = 0; j < 8; ++j) out[i][j] = silu(out[i][j]);
}
__device__ __forceinline__ void scan128(const LAS float* src, LAS float* dst, int lane) {
    const float v0 = src[2 * lane], v1 = src[2 * lane + 1]; const float s = v0 + v1; float incl = s;
#pragma unroll
    for (int o = 1; o < 64; o <<= 1) { const float t = __shfl_up(incl, o); if (lane >= o) incl += t; }
    const float excl = incl - s; dst[2 * lane] = excl + v0; dst[2 * lane + 1] = excl + s;
}
#define SSD_BAR() do { asm volatile("s_waitcnt lgkmcnt(0)" ::: "memory"); __builtin_amdgcn_s_barrier(); asm volatile("" ::: "memory"); } while (0)

__device__ __forceinline__ void chunk_unit(LAS unsigned char* lds, int b, int c, int h, const bf16_t* __restrict__ proj, const float* __restrict__ dtr, const float* __restrict__ cw, const float* __restrict__ cb,
                                           const float* __restrict__ dt_bias, const float* __restrict__ a_log, const float* __restrict__ d_skip, float* __restrict__ Y, float* __restrict__ states, float* __restrict__ cd) {
    const int tid = threadIdx.x, lane = tid & 63, r32 = lane & 31, hi = lane >> 5, w = __builtin_amdgcn_readfirstlane(tid >> 6);
    const int g = h >> 2, tok0 = b * SEQ + c * CHUNK;
    LAS float* sdt = (LAS float*)(lds + L_SDT); LAS float* sacum = (LAS float*)(lds + L_SACUM);
    const float a = -__expf(a_log[h]);
    if (tid < 128) { const float dt = softplus(dtr[(size_t)(tok0 + tid) * 8 + h] + dt_bias[h]); sdt[tid] = dt; sacum[tid] = dt * a; }
    SSD_BAR();
    if (w == 0) scan128(sacum, sacum, lane);
    SSD_BAR();
    const float aend = sacum[127];
    if (tid == 0) cd[(b * 64 + c) * 8 + h] = __expf(aend);
    for (int item = tid; item < 40 * 32; item += NTHR) {
        const int cg = item >> 5, l0 = (item & 31) * 4; float o[4][8];
        if (cg < 8) {
            conv_item(proj, cw, cb, b, c, h * 64 + cg * 8, l0, o);
#pragma unroll
            for (int i = 0; i < 4; ++i) { const int q = qpos(l0 + i);
#pragma unroll
                for (int j = 0; j < 8; ++j) *(LAS bf16_t*)(lds + L_XT + (cg * 8 + j) * PITCH + q * 2) = (bf16_t)f2bf(o[i][j]); }
        } else if (cg < 24) {
            const int n0 = (cg - 8) * 8; conv_item(proj, cw, cb, b, c, 512 + g * 128 + n0, l0, o);
#pragma unroll
            for (int i = 0; i < 4; ++i) { const int s = l0 + i, q = qpos(s); const float wl = sdt[s] * __expf(aend - sacum[s]);
                u32x4 pk; pk.x = pk2(o[i][0], o[i][1]); pk.y = pk2(o[i][2], o[i][3]); pk.z = pk2(o[i][4], o[i][5]); pk.w = pk2(o[i][6], o[i][7]);
                *(LAS u32x4*)(lds + L_BM + s * PITCH + n0 * 2) = pk;
#pragma unroll
                for (int j = 0; j < 8; ++j) *(LAS bf16_t*)(lds + L_BWT + (n0 + j) * PITCH + q * 2) = (bf16_t)f2bf(o[i][j] * wl); }
        } else {
            const int n0 = (cg - 24) * 8; conv_item(proj, cw, cb, b, c, 768 + g * 128 + n0, l0, o);
#pragma unroll
            for (int i = 0; i < 4; ++i) { u32x4 pk; pk.x = pk2(o[i][0], o[i][1]); pk.y = pk2(o[i][2], o[i][3]); pk.z = pk2(o[i][4], o[i][5]); pk.w = pk2(o[i][6], o[i][7]);
                *(LAS u32x4*)(lds + L_CM + (l0 + i) * PITCH + n0 * 2) = pk; }
        }
    }
    SSD_BAR();
    const int lb = w & 3, pb = w >> 2;
    f32x16 yacc;
#pragma unroll
    for (int r = 0; r < 16; ++r) yacc[r] = 0.f;
    const float acl = sacum[lb * 32 + r32];
#pragma unroll 1
    for (int sb = 0; sb <= lb; ++sb) {
        f32x16 X;
#pragma unroll
        for (int r = 0; r < 16; ++r) X[r] = 0.f;
#pragma unroll
        for (int ks = 0; ks < 8; ++ks) {
            const bf16x8 af = *(const LAS bf16x8*)(lds + L_BM + (sb * 32 + r32) * PITCH + (16 * ks + 8 * hi) * 2);
            const bf16x8 bfr = *(const LAS bf16x8*)(lds + L_CM + (lb * 32 + r32) * PITCH + (16 * ks + 8 * hi) * 2);
            X = SSD_MFMA(af, bfr, X);
        }
        float mv[16];
#pragma unroll
        for (int gq = 0; gq < 4; ++gq) { const int sb0 = sb * 32 + 8 * gq + 4 * hi; const f32x4 ac = *(const LAS f32x4*)(sacum + sb0), dv = *(const LAS f32x4*)(sdt + sb0);
#pragma unroll
            for (int i = 0; i < 4; ++i) { const float val = X[4 * gq + i] * __expf(acl - ac[i]) * dv[i]; const bool masked = (sb == lb) && (8 * gq + 4 * hi + i > r32); mv[4 * gq + i] = masked ? 0.f : val; } }
        u32x4 pw0, pw1;
#pragma unroll
        for (int i = 0; i < 4; ++i) { pw0[i] = cvtpk(mv[2 * i], mv[2 * i + 1]); pw1[i] = cvtpk(mv[8 + 2 * i], mv[9 + 2 * i]); }
        const bf16x8 x0 = *(const LAS bf16x8*)(lds + L_XT + (pb * 32 + r32) * PITCH + (32 * sb + 8 * hi) * 2), x1 = *(const LAS bf16x8*)(lds + L_XT + (pb * 32 + r32) * PITCH + (32 * sb + 16 + 8 * hi) * 2);
        yacc = SSD_MFMA(x0, __builtin_bit_cast(bf16x8, pw0), yacc);
        yacc = SSD_MFMA(x1, __builtin_bit_cast(bf16x8, pw1), yacc);
    }
    f32x16 st;
#pragma unroll
    for (int r = 0; r < 16; ++r) st[r] = 0.f;
#pragma unroll
    for (int ks = 0; ks < 8; ++ks) {
        const bf16x8 af = *(const LAS bf16x8*)(lds + L_BWT + (lb * 32 + r32) * PITCH + (16 * ks + 8 * hi) * 2);
        const bf16x8 bfr = *(const LAS bf16x8*)(lds + L_XT + (pb * 32 + r32) * PITCH + (16 * ks + 8 * hi) * 2);
        st = SSD_MFMA(af, bfr, st);
    }
    { const float dsk = d_skip[h]; const int l = lb * 32 + r32, ql = qpos(l); float* yrow = Y + (size_t)(tok0 + l) * 512 + h * 64 + pb * 32 + 4 * hi;
#pragma unroll
      for (int gq = 0; gq < 4; ++gq) { f32x4 o;
#pragma unroll
        for (int i = 0; i < 4; ++i) { const int p = pb * 32 + 8 * gq + 4 * hi + i; o[i] = yacc[4 * gq + i] + dsk * bf2f(*(const LAS bf16_t*)(lds + L_XT + p * PITCH + ql * 2)); }
        *(f32x4*)(yrow + 8 * gq) = o; }
      float* srow = states + ((size_t)((b * 64 + c) * 8 + h) * 64 + pb * 32 + r32) * 128 + lb * 32 + 4 * hi;
#pragma unroll
      for (int gq = 0; gq < 4; ++gq) *(f32x4*)(srow + 8 * gq) = (f32x4){st[4 * gq], st[4 * gq + 1], st[4 * gq + 2], st[4 * gq + 3]}; }
    SSD_BAR();
}

__device__ __forceinline__ void scan_phase(int vcu, int G, const float* __restrict__ states, float* __restrict__ prev, const float* __restrict__ cd) {
    for (int gid = vcu * NTHR + threadIdx.x; gid < NB * 65536; gid += G * NTHR) {
        const int b = gid >> 16, rem = gid & 65535, h = rem >> 13; const float* p = states + (size_t)b * 64 * 65536 + rem; float* q = prev + (size_t)b * 64 * 65536 + rem; const float* cdp = cd + b * 64 * 8 + h;
        float hs = 0.f;
#pragma unroll 1
        for (int c0 = 0; c0 < 64; c0 += 8) { float s[8], d[8];
#pragma unroll
            for (int i = 0; i < 8; ++i) { s[i] = p[(size_t)(c0 + i) * 65536]; d[i] = cdp[(c0 + i) * 8]; }
#pragma unroll
            for (int i = 0; i < 8; ++i) { q[(size_t)(c0 + i) * 65536] = hs; hs = hs * d[i] + s[i]; } }
    }
}

__device__ __forceinline__ void final_unit(LAS unsigned char* lds, int b, int c, int g, const bf16_t* __restrict__ proj, const float* __restrict__ dtr, const float* __restrict__ cw, const float* __restrict__ cb,
                                           const float* __restrict__ dt_bias, const float* __restrict__ a_log, const float* __restrict__ ng, const float* __restrict__ Y, const float* __restrict__ states, bf16_t* __restrict__ ycat) {
    const int tid = threadIdx.x, lane = tid & 63, r32 = lane & 31, hi = lane >> 5, w = __builtin_amdgcn_readfirstlane(tid >> 6);
    const int tok0 = b * SEQ + c * CHUNK;
    LAS float* sac = (LAS float*)(lds + F_SAC); LAS float* tmp = (LAS float*)(lds + F_TMP); LAS float* part = (LAS float*)(lds + F_PART);
    { const int j = tid >> 7, l = tid & 127, hh = 4 * g + j; const float dt = softplus(dtr[(size_t)(tok0 + l) * 8 + hh] + dt_bias[hh]); tmp[j * 128 + l] = dt * (-__expf(a_log[hh])); }
    SSD_BAR();
    if (w < 4) scan128(tmp + w * 128, sac + w * 128, lane);
    { const int cgi = tid >> 5, l0 = (tid & 31) * 4, n0 = cgi * 8; float o[4][8];
      conv_item(proj, cw, cb, b, c, 768 + g * 128 + n0, l0, o);
#pragma unroll
      for (int i = 0; i < 4; ++i) { u32x4 pk; pk.x = pk2(o[i][0], o[i][1]); pk.y = pk2(o[i][2], o[i][3]); pk.z = pk2(o[i][4], o[i][5]); pk.w = pk2(o[i][6], o[i][7]);
          *(LAS u32x4*)(lds + F_CM + (l0 + i) * PITCH + n0 * 2) = pk; } }
    SSD_BAR();
    const int j = w >> 1, pb = w & 1, head = 4 * g + j;
    bf16x8 af[8];
    { const float* sp = states + ((size_t)((b * 64 + c) * 8 + head) * 64 + pb * 32 + r32) * 128 + 8 * hi;
#pragma unroll
      for (int ks = 0; ks < 8; ++ks) { const f32x4 s0 = *(const f32x4*)(sp + 16 * ks), s1 = *(const f32x4*)(sp + 16 * ks + 4); u32x4 pk; pk.x = cvtpk(s0[0], s0[1]); pk.y = cvtpk(s0[2], s0[3]); pk.z = cvtpk(s1[0], s1[1]); pk.w = cvtpk(s1[2], s1[3]); af[ks] = __builtin_bit_cast(bf16x8, pk); } }
    float yv[4][16];
#pragma unroll
    for (int lb = 0; lb < 4; ++lb) {
        f32x16 acc;
#pragma unroll
        for (int r = 0; r < 16; ++r) acc[r] = 0.f;
#pragma unroll
        for (int ks = 0; ks < 8; ++ks) { const bf16x8 bfr = *(const LAS bf16x8*)(lds + F_CM + (lb * 32 + r32) * PITCH + (16 * ks + 8 * hi) * 2); acc = SSD_MFMA(af[ks], bfr, acc); }
        const int l = lb * 32 + r32; const float e = __expf(sac[j * 128 + l]); float ss = 0.f;
        const float* yrow = Y + (size_t)(tok0 + l) * 512 + head * 64 + pb * 32 + 4 * hi; const bf16_t* zrow = proj + (size_t)(tok0 + l) * 1536 + head * 64 + pb * 32 + 4 * hi;
#pragma unroll
        for (int gq = 0; gq < 4; ++gq) { const f32x4 yd = *(const f32x4*)(yrow + 8 * gq); const u32x2 zz = *(const u32x2*)(zrow + 8 * gq);
            const float z[4] = {__uint_as_float(zz.x << 16), __uint_as_float(zz.x & 0xffff0000u), __uint_as_float(zz.y << 16), __uint_as_float(zz.y & 0xffff0000u)};
#pragma unroll
            for (int i = 0; i < 4; ++i) { const float v = (acc[4 * gq + i] * e + yd[i]) * silu(z[i]); yv[lb][4 * gq + i] = v; ss += v * v; } }
        ss += __shfl_xor(ss, 32);
        if (hi == 0) part[l * 8 + w] = ss;
    }
    SSD_BAR();
#pragma unroll
    for (int lb = 0; lb < 4; ++lb) { const int l = lb * 32 + r32; const f32x4 p0 = *(const LAS f32x4*)(part + l * 8), p1 = *(const LAS f32x4*)(part + l * 8 + 4);
        const float rstd = rsqrtf(((p0[0] + p0[1]) + (p0[2] + p0[3]) + (p1[0] + p1[1]) + (p1[2] + p1[3])) * (1.f / 256.f) + EPS);
        bf16_t* orow = ycat + (size_t)(tok0 + l) * DM + head * 64 + pb * 32 + 4 * hi; const float* gp = ng + head * 64 + pb * 32 + 4 * hi;
#pragma unroll
        for (int gq = 0; gq < 4; ++gq) { const f32x4 gg = *(const f32x4*)(gp + 8 * gq); u32x2 o; o.x = cvtpk(yv[lb][4 * gq] * rstd * gg[0], yv[lb][4 * gq + 1] * rstd * gg[1]); o.y = cvtpk(yv[lb][4 * gq + 2] * rstd * gg[2], yv[lb][4 * gq + 3] * rstd * gg[3]);
            *(u32x2*)(orow + 8 * gq) = o; } }
    SSD_BAR();
}
}

constexpr int CNT_STRIDE = 64;
__device__ __forceinline__ void router_phase(LAS unsigned char* lds, int vcu, int G, const float* __restrict__ x1, const float* __restrict__ g, const float* __restrict__ wr, const float* __restrict__ br, unsigned char* __restrict__ h2,
                                             u32* __restrict__ cnt, int* __restrict__ list, float* __restrict__ listg, int* __restrict__ toke, int* __restrict__ tokp) {
    const int tid = threadIdx.x, lane = tid & 63, w = __builtin_amdgcn_readfirstlane(tid >> 6), e = lane & 31, half = lane >> 5;
    LAS float* hvs = (LAS float*)(lds + w * 16384);
    LAS int* ssel = (LAS int*)(lds + LDSCTL_OFF + 1024); LAS float* sgw = (LAS float*)(lds + LDSCTL_OFF + 2048);
    LAS unsigned* hist = (LAS unsigned*)(lds + LDSCTL_OFF + 3072); LAS unsigned* sbase = hist + 32;
    const f32x4 br4 = *(const f32x4*)(br + 4 * (lane & 7));
#pragma unroll 1
    for (int grp = vcu; grp < NTOK / 64; grp += G) {
        if (tid < 32) hist[tid] = 0u;
#pragma unroll 1
        for (int bt = 0; bt < 2; ++bt) {
            const int tl0 = w * 8 + bt * 4, tok0 = grp * 64 + tl0;
#pragma unroll
            for (int t = 0; t < 4; ++t) {
                const f32x4* xr = (const f32x4*)(x1 + (size_t)(tok0 + t) * DM) + lane; f32x4 v[4]; float ss = 0.f;
#pragma unroll
                for (int j = 0; j < 4; ++j) { v[j] = xr[64 * j]; ss += v[j].x * v[j].x + v[j].y * v[j].y + v[j].z * v[j].z + v[j].w * v[j].w; }
                const float r = rsqrtf(wave_sum(ss) * (1.f / DM) + EPS);
#pragma unroll
                for (int j = 0; j < 4; ++j) { const f32x4 gg = ((const f32x4*)g)[lane + 64 * j]; const f32x4 hv = {v[j].x * r * gg.x, v[j].y * r * gg.y, v[j].z * r * gg.z, v[j].w * r * gg.w};
                    *(u32*)(h2 + (size_t)(tok0 + t) * DM + 4 * (lane + 64 * j)) = pk4_fp8(hv[0], hv[1], hv[2], hv[3]);
                    *(LAS f32x4*)(hvs + t * 1024 + 4 * (lane + 64 * j)) = hv; }
            }
            asm volatile("s_waitcnt lgkmcnt(0)" ::: "memory");
            float acc[4][4];
#pragma unroll
            for (int t = 0; t < 4; ++t)
#pragma unroll
                for (int q = 0; q < 4; ++q) acc[t][q] = 0.f;
            const int e4 = lane & 7, dsb = lane >> 3;
            const float* wp = wr + (size_t)(dsb * 128) * NE + 4 * e4; const LAS float* hp = hvs + dsb * 128;
#pragma unroll 2
            for (int d = 0; d < 128; d += 4) {
                f32x4 wv[4];
#pragma unroll
                for (int i = 0; i < 4; ++i) wv[i] = *(const f32x4*)(wp + (size_t)(d + i) * NE);
#pragma unroll
                for (int t = 0; t < 4; ++t) { const f32x4 h0 = *(const LAS f32x4*)(hp + t * 1024 + d);
#pragma unroll
                    for (int q = 0; q < 4; ++q) acc[t][q] += (h0[0] * wv[0][q] + h0[1] * wv[1][q]) + (h0[2] * wv[2][q] + h0[3] * wv[3][q]); }
            }
#pragma unroll
            for (int t = 0; t < 4; ++t)
#pragma unroll
                for (int q = 0; q < 4; ++q) { float v = acc[t][q]; v += __shfl_xor(v, 8); v += __shfl_xor(v, 16); v += __shfl_xor(v, 32); acc[t][q] = v + br4[q]; }
#pragma unroll
            for (int t = 0; t < 4; ++t) {
                int sel[4]; float sv[4];
#pragma unroll
                for (int k = 0; k < 4; ++k) { float bv = acc[t][0]; int bi = 4 * e4;
#pragma unroll
                    for (int q = 1; q < 4; ++q) if (acc[t][q] > bv) { bv = acc[t][q]; bi = 4 * e4 + q; }
#pragma unroll
                    for (int o = 1; o < 8; o <<= 1) { const float ov = __shfl_xor(bv, o); const int oi = __shfl_xor(bi, o); if (ov > bv || (ov == bv && oi < bi)) { bv = ov; bi = oi; } }
                    sel[k] = bi; sv[k] = bv;
#pragma unroll
                    for (int q = 0; q < 4; ++q) if (bi == 4 * e4 + q) acc[t][q] = -3.0e38f; }
                const float e1 = __expf(sv[1] - sv[0]), e2 = __expf(sv[2] - sv[0]), e3 = __expf(sv[3] - sv[0]), inv = 1.f / (1.f + e1 + e2 + e3);
                if (lane == 0) { *(LAS u32x4*)(ssel + (tl0 + t) * 4) = (u32x4){(u32)sel[0], (u32)sel[1], (u32)sel[2], (u32)sel[3]}; *(LAS f32x4*)(sgw + (tl0 + t) * 4) = (f32x4){inv, e1 * inv, e2 * inv, e3 * inv}; }
            }
        }
        SSD_BAR();
        int myE = 0; unsigned rank = 0u;
        if (tid < 256) { myE = ssel[tid]; rank = __hip_atomic_fetch_add(hist + myE, 1u, __ATOMIC_RELAXED, __HIP_MEMORY_SCOPE_WORKGROUP); }
        SSD_BAR();
        if (tid < 32) { const unsigned c = hist[tid]; sbase[tid] = c ? atomicAdd(cnt + tid * CNT_STRIDE, c) : 0u; }
        SSD_BAR();
        if (tid < 256) { const unsigned p = sbase[myE] + rank; const int tok = grp * 64 + (tid >> 2);
            list[(size_t)myE * NTOK + p] = tok; listg[(size_t)myE * NTOK + p] = sgw[tid]; toke[tok * 4 + (tid & 3)] = myE; tokp[tok * 4 + (tid & 3)] = (int)p; }
        SSD_BAR();
    }
}
__device__ __forceinline__ void combine_phase(int gw, int NGW, int lane, const float* __restrict__ x1, const bf16_t* __restrict__ ys, const u32* __restrict__ cnt, const int* __restrict__ toke, const int* __restrict__ tokp, const float* __restrict__ g, float* __restrict__ out) {
    int tiles = lane < 32 ? (int)((cnt[(lane & 31) * CNT_STRIDE] + 127) >> 7) : 0, incl = tiles;
#pragma unroll
    for (int o = 1; o < 32; o <<= 1) { const int t = __shfl_up(incl, o); if ((lane & 31) >= o) incl += t; }
    const int excl = (incl - tiles) << 7;
#pragma unroll 1
    for (int tok = gw; tok < NTOK; tok += NGW) {
        f32x4 v[4];
#pragma unroll
        for (int j = 0; j < 4; ++j) v[j] = ((const f32x4*)(x1 + (size_t)tok * DM))[lane + 64 * j];
#pragma unroll
        for (int k = 0; k < 4; ++k) { const int e = toke[tok * 4 + k], p = tokp[tok * 4 + k]; const int srow = __shfl(excl, e) + p; const bf16_t* yr = ys + (size_t)srow * DM;
#pragma unroll
            for (int j = 0; j < 4; ++j) { const u32x2 w = *(const u32x2*)(yr + 4 * (lane + 64 * j));
                v[j].x += __uint_as_float(w.x << 16); v[j].y += __uint_as_float(w.x & 0xffff0000u); v[j].z += __uint_as_float(w.y << 16); v[j].w += __uint_as_float(w.y & 0xffff0000u); } }
        float ss = 0.f;
#pragma unroll
        for (int j = 0; j < 4; ++j) ss += v[j].x * v[j].x + v[j].y * v[j].y + v[j].z * v[j].z + v[j].w * v[j].w;
        const float r = rsqrtf(wave_sum(ss) * (1.f / DM) + EPS);
#pragma unroll
        for (int j = 0; j < 4; ++j) { const f32x4 gg = ((const f32x4*)g)[lane + 64 * j]; ((f32x4*)(out + (size_t)tok * DM))[lane + 64 * j] = (f32x4){v[j].x * r * gg.x, v[j].y * r * gg.y, v[j].z * r * gg.z, v[j].w * r * gg.w}; }
    }
}

struct Frame { LAS unsigned char* lds; int tid, lane, wave, G, vcu; };

__device__ __forceinline__ void p0_prologue(const Frame& F, const Args& a) {
    unsigned char* ws = a.ws;
    const int gw = F.vcu * NWAVES + F.wave, NGW = F.G * NWAVES;
    constexpr int T_IN = 16 * 32, T_UQ = 4 * 12, T_KN = 2 * 8, T_V = 2 * 8, T_OUT = 16 * 16, T_GU = 16 * 32, T_DN = 16 * 16;
    constexpr int NT = T_IN + T_UQ + T_KN + T_V + T_OUT + NE * T_GU + NE * T_DN;
    for (int it = gw; it < NT; it += NGW) {
        int r = it;
        if (r < T_IN) { p0_tile((const float*)a.in[3], IN_W, 1024, nullptr, (bf16_t*)(ws + WS_WIN), (r >> 5) * 64, (r & 31) * 64, MapIn{}, F.lane); continue; } r -= T_IN;
        if (r < T_UQ) { p0_tile((const float*)a.in[11], 768, 256, (const float*)a.in[10], (bf16_t*)(ws + WS_WUQ), (r / 12) * 64, (r % 12) * 64, MapQ{}, F.lane); continue; } r -= T_UQ;
        if (r < T_KN) { p0_tile((const float*)a.in[13], 1024, 128, (const float*)a.in[12], (bf16_t*)(ws + WS_WKN), (r >> 3) * 64, (r & 7) * 64, MapKn{}, F.lane); continue; } r -= T_KN;
        if (r < T_V) { p0_tile((const float*)a.in[13], 1024, 128, (const float*)a.in[12], (bf16_t*)(ws + WS_WV), (r >> 3) * 64, (r & 7) * 64, MapV{}, F.lane); continue; } r -= T_V;
        if (r < T_OUT) { p0_tile((const float*)a.in[14], 1024, 1024, nullptr, (bf16_t*)(ws + WS_WOUT), (r >> 4) * 64, (r & 15) * 64, MapId{}, F.lane); continue; } r -= T_OUT;
        if (r < NE * T_GU) { const int e = r / T_GU, q = r % T_GU; p0_tile8((const float*)a.in[18] + (size_t)e * 1024 * 2048, 2048, 1024, (unsigned char*)(ws + WS_WGU) + (size_t)e * 2048 * 1024, (q >> 5) * 64, (q & 31) * 64, MapGU{}, F.lane); continue; } r -= NE * T_GU;
        { const int e = r / T_DN, q = r % T_DN; p0_tile8((const float*)a.in[20] + (size_t)e * 1024 * 1024, 1024, 1024, (unsigned char*)(ws + WS_WDN) + (size_t)e * 1024 * 1024, (q >> 4) * 64, (q & 15) * 64, MapId{}, F.lane); }
    }
    { const float* x = (const float*)a.in[0]; const float* g = (const float*)a.in[2]; bf16_t* H = (bf16_t*)(ws + WS_H);
      for (int row = gw; row < NTOK; row += NGW) {
        const f32x4* xr = (const f32x4*)(x + (size_t)row * DM) + F.lane; f32x4 v[4]; float ss = 0.f;
#pragma unroll
        for (int j = 0; j < 4; ++j) { v[j] = xr[64 * j]; ss += v[j].x * v[j].x + v[j].y * v[j].y + v[j].z * v[j].z + v[j].w * v[j].w; }
        const float r = rsqrtf(wave_sum(ss) * (1.f / DM) + EPS);
#pragma unroll
        for (int j = 0; j < 4; ++j) { const f32x4 gg = ((const f32x4*)g)[F.lane + 64 * j]; u32x2 w; w.x = pk2(v[j].x * r * gg.x, v[j].y * r * gg.y); w.y = pk2(v[j].z * r * gg.z, v[j].w * r * gg.w);
            *(u32x2*)(H + (size_t)row * DM + 4 * (F.lane + 64 * j)) = w; }
      } }
    { const int* pos = (const int*)a.in[1]; float* rc = (float*)(ws + WS_ROPEC); float* rs = (float*)(ws + WS_ROPES);
      for (int idx = F.vcu * NTHR + F.tid; idx < NTOK * 16; idx += F.G * NTHR) { const int tok = idx >> 4, i = idx & 15;
        double t = (double)pos[tok] * INVF2PI[i]; t -= floor(t); const float fr = (float)t; rc[idx] = __builtin_amdgcn_cosf(fr); rs[idx] = __builtin_amdgcn_sinf(fr); } }
}

#ifndef PROBE_REP
#define PROBE_REP -1
#endif
#define REPS(k) for (int rep_ = 0; rep_ < ((PROBE_REP) == (k) ? 2 : 1); ++rep_)
__global__ void __launch_bounds__(NTHR, 2) mega(Args args) {
    extern __shared__ __attribute__((aligned(16))) unsigned char lds_raw[];
    Frame F; F.lds = (LAS unsigned char*)lds_raw;
    F.tid = threadIdx.x; F.lane = F.tid & 63; F.wave = __builtin_amdgcn_readfirstlane(F.tid >> 6);
    F.G = gridDim.x; { const int bx = blockIdx.x; F.vcu = (F.G % 8 == 0) ? (bx % 8) * (F.G / 8) + bx / 8 : bx; }
    volatile LAS unsigned* MISC = (volatile LAS unsigned*)(F.lds + MISC_OFF);
    for (int u = F.tid; u < (LDS_BYTES - LDSCTL_OFF) / 4; u += NTHR) ((LAS unsigned*)(F.lds + LDSCTL_OFF))[u] = 0u;
    __syncthreads();
    unsigned char* ws = args.ws;
    unsigned* ctl = (unsigned*)(ws + WS_CTL);
    const int lo = args.ph_lo, hi = args.ph_hi;
    XcdBarrier bar; bar.bar = ctl + CW_BAR; bar.x = 0; bar.st = nullptr;
    if (hi - lo > 1) bar = xcd_barrier_post(ctl + CW_BAR, MISC + 8);
#define IN(k) (lo <= (k) && (k) < hi)
#define SEAM(k) do { if (IN(k) && IN((k) + 1)) { xcd_barrier(bar); if (PROBE_REP == 100) xcd_barrier(bar); } } while (0)

    if (IN(0)) REPS(0) { p0_prologue(F, args); } SEAM(0);
    if (IN(1)) REPS(1) {
        pg8::GridOrder S{(const char*)(ws + WS_H), (const char*)(ws + WS_WIN), 1024, NTOK / 256, 2048 / 256, F.G, F.vcu, 0};
        pg8::EpiInprojMfma E{EpiInproj{(bf16_t*)(ws + WS_PROJ), (bf16_t*)(ws + WS_CQ), (bf16_t*)(ws + WS_CKV), (float*)(ws + WS_DT), (bf16_t*)(ws + WS_K), (const float*)(ws + WS_ROPEC), (const float*)(ws + WS_ROPES)},
                             (float*)(ws + WS_PARTQ), (float*)(ws + WS_PARTKV), (LAS float*)(F.lds + LDSCTL_OFF + 1024)};
        pg8::gemm_phase(F.lds, 1024, S, E);
    } SEAM(1);
    if (IN(2)) {
        {
        REPS(22) { pg8::GridOrderRot S{(const char*)(ws + WS_CQ), (const char*)(ws + WS_WUQ), 256, NTOK / 256, 3, F.G, F.vcu, 0};
          pg8::EpiRows<EpiQ> E{EpiQ{(bf16_t*)(ws + WS_Q), (const float*)(ws + WS_PARTQ), (const float*)(ws + WS_ROPEC), (const float*)(ws + WS_ROPES)}};
          pg8::gemm_phase(F.lds, 256, S, E); }
        REPS(23) { pg8::GridOrderRot S{(const char*)(ws + WS_CKV), (const char*)(ws + WS_WKN), 128, NTOK / 256, 2, F.G, F.vcu, 192};
          pg8::EpiRows<EpiKn> E{EpiKn{(bf16_t*)(ws + WS_K), (const float*)(ws + WS_PARTKV)}};
          pg8::gemm_phase(F.lds, 128, S, E); }
        REPS(24) { pg8::GridOrderRot S{(const char*)(ws + WS_WV), (const char*)(ws + WS_CKV), 128, 2, NTOK / 256, F.G, F.vcu, 64};
          pg8::EpiColsVt E{(bf16_t*)(ws + WS_VT), (const float*)(ws + WS_PARTKV)};
          pg8::gemm_phase(F.lds, 128, S, E); }
        }
        REPS(21) for (int u = F.vcu; u < NB * 64 * NH; u += F.G)
            ssd::chunk_unit(F.lds, u >> 9, (u >> 3) & 63, u & 7, (const bf16_t*)(ws + WS_PROJ), (const float*)(ws + WS_DT), (const float*)args.in[4], (const float*)args.in[5], (const float*)args.in[6], (const float*)args.in[7], (const float*)args.in[8],
                            (float*)(ws + WS_Y), (float*)(ws + WS_STATES), (float*)(ws + WS_CD));
    } SEAM(2);
    if (IN(3)) REPS(3) { ssd::scan_phase(F.vcu, F.G, (const float*)(ws + WS_STATES), (float*)(ws + WS_PREV), (const float*)(ws + WS_CD)); } SEAM(3);
    if (IN(4)) {
        REPS(40) for (int u = F.vcu; u < NB * 64 * NG; u += F.G)
            ssd::final_unit(F.lds, u >> 7, (u >> 1) & 63, u & 1, (const bf16_t*)(ws + WS_PROJ), (const float*)(ws + WS_DT), (const float*)args.in[4], (const float*)args.in[5], (const float*)args.in[6], (const float*)args.in[7], (const float*)args.in[9],
                            (const float*)(ws + WS_Y), (const float*)(ws + WS_PREV), (bf16_t*)(ws + WS_YCAT));
        REPS(41) att::attn_phase(F.lds, F.vcu, F.G, (const bf16_t*)(ws + WS_Q), (const bf16_t*)(ws + WS_K), (const bf16_t*)(ws + WS_VT), (bf16_t*)(ws + WS_YCAT));
    } SEAM(4);
    if (IN(5)) REPS(5) {
        pg8::GridOrder S{(const char*)(ws + WS_YCAT), (const char*)(ws + WS_WOUT), 1024, NTOK / 256, 4, F.G, F.vcu, 0};
        pg8::EpiRows<EpiOut> E{EpiOut{(const float*)args.in[0], (float*)(ws + WS_X1)}};
        pg8::gemm_phase(F.lds, 1024, S, E);
    } SEAM(5);
    if (IN(6)) REPS(6) { const size_t dm = (PROBE_REP == 6 && rep_ == 1) ? 4 * MiB : 0;
                 router_phase(F.lds, F.vcu, F.G, (const float*)(ws + WS_X1), (const float*)args.in[15], (const float*)args.in[16], (const float*)args.in[17], (unsigned char*)(ws + WS_H2),
                              (u32*)(ctl + CW_CNT + (dm ? 8192 : 0)), (int*)(ws + (dm ? WS_END : WS_LIST)), (float*)(ws + (dm ? WS_END + 2 * MiB : WS_LISTG)), (int*)(ws + (dm ? WS_END + 4 * MiB : WS_TOKE)), (int*)(ws + (dm ? WS_END + 5 * MiB : WS_TOKP))); } SEAM(6);
    if (IN(7)) REPS(7) {
        g8::MoeOrder<true> S{(const char*)(ws + WS_H2), (const char*)(ws + WS_WGU), (const u32*)(ctl + CW_CNT), (const int*)(ws + WS_LIST), 1024, 8, 2048, F.G, F.vcu, 0};
        g8::EpiMoeGlu E{(unsigned char*)(ws + WS_ACT), (const float*)args.in[19]};
        g8::gemm_phase(F.lds, 1024, S, E);
    } SEAM(7);
    if (IN(8)) REPS(8) {
        g8::MoeOrder<false> S{(const char*)(ws + WS_ACT), (const char*)(ws + WS_WDN), (const u32*)(ctl + CW_CNT), (const int*)(ws + WS_LIST), 1024, 4, 1024, F.G, F.vcu, 0};
        g8::EpiMoeDown E{(bf16_t*)(ws + WS_YS), (const float*)args.in[21], (const float*)(ws + WS_LISTG)};
        g8::gemm_phase(F.lds, 1024, S, E);
    } SEAM(8);
    if (IN(9)) REPS(9) { combine_phase(F.vcu * NWAVES + F.wave, F.G * NWAVES, F.lane, (const float*)(ws + WS_X1), (const bf16_t*)(ws + WS_YS), (const u32*)(ctl + CW_CNT), (const int*)(ws + WS_TOKE), (const int*)(ws + WS_TOKP), (const float*)args.in[22], args.out); }
#undef IN
#undef SEAM
}

static int g_grid = 0;
static void launch_mega(Args a, int lo, int hi, hipStream_t s) { a.ph_lo = lo; a.ph_hi = hi; hipLaunchKernelGGL(mega, dim3(g_grid), dim3(NTHR), LDS_BYTES, s, a); }
extern "C" void kernel_launch(void* const* d_in, const int* in_sizes, int n_in, void* d_out, int out_size, void* d_ws, size_t ws_size, hipStream_t stream) {
    if (n_in != 23 || in_sizes[0] != NTOK * DM || out_size != NTOK * DM || ws_size < WS_END) { fprintf(stderr, "kernel_launch: unexpected shapes (n_in %d, ws %zu)\n", n_in, ws_size); return; }
    if (g_grid == 0) {
        int dev = 0, cus = 0;
        if (hipGetDevice(&dev) != hipSuccess || hipDeviceGetAttribute(&cus, hipDeviceAttributeMultiprocessorCount, dev) != hipSuccess) { fprintf(stderr, "kernel_launch: device query failed\n"); g_grid = -1; return; }
        if (hipFuncSetAttribute((const void*)mega, hipFuncAttributeMaxDynamicSharedMemorySize, LDS_BYTES) != hipSuccess) { fprintf(stderr, "kernel_launch: hipFuncSetAttribute failed\n"); g_grid = -1; return; }
        (void)hipGetLastError();
        g_grid = cus;
    }
    if (g_grid < 0) return;
    const float* x = (const float*)d_in[0];
    const float* conv_w = (const float*)d_in[4]; const float* conv_b = (const float*)d_in[5]; const float* dt_bias = (const float*)d_in[6]; const float* a_log = (const float*)d_in[7];
    const float* d_skip = (const float*)d_in[8]; const float* ssd_norm_g = (const float*)d_in[9]; const float* q_norm_g = (const float*)d_in[10]; const float* w_uq = (const float*)d_in[11];
    const float* kv_norm_g = (const float*)d_in[12]; const float* w_ukv = (const float*)d_in[13]; const float* w_out = (const float*)d_in[14]; const float* norm_ffn_g = (const float*)d_in[15];
    const float* w_router = (const float*)d_in[16]; const float* b_router = (const float*)d_in[17]; const float* w_gate_up = (const float*)d_in[18]; const float* b_gate_up = (const float*)d_in[19];
    const float* w_down = (const float*)d_in[20]; const float* b_down = (const float*)d_in[21]; const float* norm_final_g = (const float*)d_in[22];
    char* ws = (char*)d_ws; float* out = (float*)d_out;
    u32* ctl = (u32*)(ws + WS_CTL); float* ropec = (float*)(ws + WS_ROPEC); float* ropes = (float*)(ws + WS_ROPES);
    bf16_t* PROJ = (bf16_t*)(ws + WS_PROJ); bf16_t* CQ = (bf16_t*)(ws + WS_CQ); bf16_t* CKV = (bf16_t*)(ws + WS_CKV);
    float* DT = (float*)(ws + WS_DT); float* PARTQ = (float*)(ws + WS_PARTQ); float* PARTKV = (float*)(ws + WS_PARTKV);
    bf16_t* Qb = (bf16_t*)(ws + WS_Q); bf16_t* Kb = (bf16_t*)(ws + WS_K); bf16_t* VTb = (bf16_t*)(ws + WS_VT);
    float* Y = (float*)(ws + WS_Y); bf16_t* YCAT = (bf16_t*)(ws + WS_YCAT); float* X1 = (float*)(ws + WS_X1); bf16_t* H2 = (bf16_t*)(ws + WS_H2);
    int* TOKE = (int*)(ws + WS_TOKE); int* TOKP = (int*)(ws + WS_TOKP); int* LIST = (int*)(ws + WS_LIST); float* LISTG = (float*)(ws + WS_LISTG);
    bf16_t* ACT = (bf16_t*)(ws + WS_ACT); bf16_t* YS = (bf16_t*)(ws + WS_YS); float* XBCC = (float*)(ws + WS_XBCC);
    Args a{}; for (int i = 0; i < 23; ++i) a.in[i] = d_in[i]; a.out = out; a.ws = (unsigned char*)d_ws;

    (void)hipMemsetAsync(ws + WS_CTL, 0, CTL_BYTES, stream);
    launch_mega(a, 0, 10, stream);
}
```

```cpp
#include <hip/hip_runtime.h>
#include <cstdio>
#include <cstdint>

typedef unsigned short bf16_t;
typedef unsigned u32;
typedef float f32x4 __attribute__((ext_vector_type(4)));
typedef unsigned u32x4 __attribute__((ext_vector_type(4)));
typedef unsigned u32x2 __attribute__((ext_vector_type(2)));
#define DI __device__ __forceinline__

constexpr int NB = 2, SEQ = 8192, DM = 1024, NTOK = NB * SEQ;
constexpr int IN_W = 1960;
constexpr int NH = 8, HP = 64, NG = 2, NST = 128, CHUNK = 128;
constexpr int QK = 96, NOPE = 64, ROPE = 32, VD = 64;
constexpr int NE = 32, TOPK = 4, DFF = 1024;
constexpr float EPS = 1e-6f;
constexpr float QSCALE = 0.14724444602590306f;
constexpr int SLOT_ROWS = NTOK * TOPK + NE * 256;

constexpr size_t MiB = 1u << 20;
constexpr size_t WS_CTL = 0, CTL_BYTES = 1 * MiB;
constexpr size_t WS_ROPEC = 1 * MiB, WS_ROPES = 2 * MiB;
constexpr size_t WS_H = 208 * MiB;
constexpr size_t WS_PROJ = 240 * MiB;
constexpr size_t WS_CQ = 288 * MiB;
constexpr size_t WS_CKV = 296 * MiB;
constexpr size_t WS_DT = 300 * MiB;
constexpr size_t WS_PARTQ = 301 * MiB;
constexpr size_t WS_PARTKV = 303 * MiB;
constexpr size_t WS_Q = 304 * MiB;
constexpr size_t WS_K = 328 * MiB;
constexpr size_t WS_VT = 352 * MiB;
constexpr size_t WS_Y = 368 * MiB;
constexpr size_t WS_STATES = 400 * MiB;
constexpr size_t WS_CD = 432 * MiB;
constexpr size_t WS_YCAT = 434 * MiB;
constexpr size_t WS_X1 = 466 * MiB;
constexpr size_t WS_H2 = 530 * MiB;
constexpr size_t WS_TOKE = 562 * MiB;
constexpr size_t WS_TOKP = WS_TOKE + 256 * 1024;
constexpr size_t WS_LIST = 563 * MiB;
constexpr size_t WS_LISTG = 565 * MiB;
constexpr size_t WS_ACT = 568 * MiB;
constexpr size_t WS_YS = 712 * MiB;
constexpr size_t WS_XBCC = 712 * MiB;
constexpr size_t WS_PREV = 856 * MiB;
constexpr size_t WS_END = 888 * MiB;
constexpr int CW_CNT = 64;

DI float bf2f(bf16_t v) { return __uint_as_float((u32)v << 16); }
DI u32 f2bf(float f) { u32 u = __float_as_uint(f); return (u + 0x7fffu + ((u >> 16) & 1u)) >> 16; }
DI u32 pk2(float lo, float hi) { return f2bf(lo) | (f2bf(hi) << 16); }
DI void store8(bf16_t* p, const float (&v)[8]) { u32x4 w; w.x = pk2(v[0], v[1]); w.y = pk2(v[2], v[3]); w.z = pk2(v[4], v[5]); w.w = pk2(v[6], v[7]); *(u32x4*)p = w; }
DI void load8(const bf16_t* p, float (&v)[8]) { const u32x4 w = *(const u32x4*)p;
    v[0] = __uint_as_float(w.x << 16); v[1] = __uint_as_float(w.x & 0xffff0000u); v[2] = __uint_as_float(w.y << 16); v[3] = __uint_as_float(w.y & 0xffff0000u);
    v[4] = __uint_as_float(w.z << 16); v[5] = __uint_as_float(w.z & 0xffff0000u); v[6] = __uint_as_float(w.w << 16); v[7] = __uint_as_float(w.w & 0xffff0000u); }
DI u32 pk4_fp8(float a, float b, float c, float d) { int w = __builtin_amdgcn_cvt_pk_fp8_f32(a, b, 0, false); w = __builtin_amdgcn_cvt_pk_fp8_f32(c, d, w, true); return (u32)w; }
constexpr float W8_SCALE = 32.f, W8_INV = 1.f / 32.f;
DI float wave_sum(float v) {
#pragma unroll
    for (int o = 1; o < 64; o <<= 1) v += __shfl_xor(v, o);
    return v;
}
DI float silu(float v) { return v / (1.f + __expf(-v)); }
DI size_t qk_off(int b, int h, int s, int dc) { return ((((size_t)(b * NH + h) * 128 + (s >> 6)) * 12 + dc) * 64 + (s & 63)) * 8; }
DI size_t vt_off(int b, int h, int s, int d) {
    const int sl = s & 63, g16 = sl >> 4, w = sl & 15, a = (w >> 3) & 1, bb = (w >> 2) & 1, c = w & 3;
    return ((((size_t)(b * NH + h) * 128 + (s >> 6)) * 8 + (2 * g16 + bb)) * 64 + d) * 8 + 4 * a + c;
}
__host__ __device__ inline int inproj_src_col(int c) {
    if (c < 1536) return c;
    if (c < 1792) return 1544 + (c - 1536);
    if (c < 1920) return 1800 + (c - 1792);
    if (c < 1952) { const int i = c - 1920; return 1928 + (i >> 1) + ((i & 1) ? 16 : 0); }
    if (c < 1960) return 1536 + (c - 1952);
    return -1;
}
__host__ __device__ inline int q_src_col(int c) { const int h = c / 96, r = c - h * 96; if (r < 64) return h * 96 + r; const int i = r - 64; return h * 96 + 64 + (i >> 1) + ((i & 1) ? 16 : 0); }

__device__ const double INVF2PI[16] = {0.15915494309189535, 0.08949940160889101, 0.050329212104487035, 0.0283021958306234, 0.015915494309189534, 0.0089499401608891, 0.005032921210448704, 0.00283021958306234,
                                      0.0015915494309189536, 0.0008949940160889102, 0.0005032921210448703, 0.00028302195830623395, 0.00015915494309189535, 8.9499401608891e-05, 5.0329212104487035e-05, 2.83021958306234e-05};

__global__ __launch_bounds__(256) void k_rope_table(const int* __restrict__ pos, float* __restrict__ rc, float* __restrict__ rs) {
    const int idx = blockIdx.x * 256 + threadIdx.x; if (idx >= NTOK * 16) return;
    const int tok = idx >> 4, i = idx & 15;
    double t = (double)pos[tok] * INVF2PI[i]; t -= floor(t);
    const float fr = (float)t;
    rc[idx] = __builtin_amdgcn_cosf(fr); rs[idx] = __builtin_amdgcn_sinf(fr);
}
__global__ __launch_bounds__(256) void k_rmsnorm_bf16(const float* __restrict__ x, const float* __restrict__ g, bf16_t* __restrict__ out) {
    const int row = blockIdx.x * 4 + (threadIdx.x >> 6), lane = threadIdx.x & 63;
    const f32x4* xr = (const f32x4*)(x + (size_t)row * DM) + lane; f32x4 v[4]; float ss = 0.f;
#pragma unroll
    for (int j = 0; j < 4; ++j) { v[j] = xr[64 * j]; ss += v[j].x * v[j].x + v[j].y * v[j].y + v[j].z * v[j].z + v[j].w * v[j].w; }
    const float r = rsqrtf(wave_sum(ss) * (1.f / DM) + EPS);
#pragma unroll
    for (int j = 0; j < 4; ++j) { const f32x4 gg = ((const f32x4*)g)[lane + 64 * j]; u32x2 w; w.x = pk2(v[j].x * r * gg.x, v[j].y * r * gg.y); w.y = pk2(v[j].z * r * gg.z, v[j].w * r * gg.w);
        *(u32x2*)(out + (size_t)row * DM + 4 * (lane + 64 * j)) = w; }
}

struct EpiInproj {
    bf16_t* proj; bf16_t* cq; bf16_t* ckv; float* dt; bf16_t* kbuf; const float* ropec; const float* ropes;
    DI float rowctx(int) const { return 1.f; }
    DI void operator()(int row, int col0, const float (&v)[8], float) const {
        if (col0 < 1536) { store8(proj + (size_t)row * 1536 + col0, v); }
        else if (col0 < 1792) { store8(cq + (size_t)row * 256 + (col0 - 1536), v); }
        else if (col0 < 1920) { store8(ckv + (size_t)row * 128 + (col0 - 1792), v); }
        else if (col0 < 1952) { const int i0 = (col0 - 1920) >> 1; float o[8];
#pragma unroll
            for (int m = 0; m < 4; ++m) { const float c = ropec[(size_t)row * 16 + i0 + m], s = ropes[(size_t)row * 16 + i0 + m]; o[2 * m] = v[2 * m] * c - v[2 * m + 1] * s; o[2 * m + 1] = v[2 * m + 1] * c + v[2 * m] * s; }
            const int b = row >> 13, s_ = row & (SEQ - 1), dc = 8 + ((col0 - 1920) >> 3);
#pragma unroll
            for (int h = 0; h < NH; ++h) store8(kbuf + qk_off(b, h, s_, dc), o); }
        else if (col0 == 1952) { *(f32x4*)(dt + (size_t)row * 8) = (f32x4){v[0], v[1], v[2], v[3]}; *(f32x4*)(dt + (size_t)row * 8 + 4) = (f32x4){v[4], v[5], v[6], v[7]}; }
    }
};
DI float part_sum(const float* p, int n4) { float s = 0.f; for (int i = 0; i < n4; ++i) { const f32x4 t = ((const f32x4*)p)[i]; s += (t.x + t.y) + (t.z + t.w); } return s; }
struct EpiQ {
    bf16_t* q; const float* partq; const float* ropec; const float* ropes;
    DI float rowctx(int row) const { return partq[row] * QSCALE; }
    DI void operator()(int row, int col0, const float (&v)[8], float rs) const {
        const int h = col0 / 96, c = col0 - h * 96; float o[8];
        if (c < 64) {
#pragma unroll
            for (int j = 0; j < 8; ++j) o[j] = v[j] * rs;
        } else { const int i0 = (c - 64) >> 1;
#pragma unroll
            for (int m = 0; m < 4; ++m) { const float cc = ropec[(size_t)row * 16 + i0 + m], ss = ropes[(size_t)row * 16 + i0 + m]; const float a = v[2 * m] * rs, b = v[2 * m + 1] * rs; o[2 * m] = a * cc - b * ss; o[2 * m + 1] = b * cc + a * ss; } }
        store8(q + qk_off(row >> 13, h, row & (SEQ - 1), c >> 3), o);
    }
};
struct EpiKn {
    bf16_t* k; const float* partkv;
    DI float rowctx(int row) const { return partkv[row]; }
    DI void operator()(int row, int col0, const float (&v)[8], float rs) const {
        const int h = col0 >> 6, c = col0 & 63; float o[8];
#pragma unroll
        for (int j = 0; j < 8; ++j) o[j] = v[j] * rs;
        store8(k + qk_off(row >> 13, h, row & (SEQ - 1), c >> 3), o);
    }
};
struct EpiVt {
    bf16_t* vt; const float* partkv;
    DI float rowctx(int) const { return 1.f; }
    DI void operator()(int row, int tok0, const float (&v)[8], float) const {
        const int h = row >> 6, d = row & 63; float o[8];
#pragma unroll
        for (int j = 0; j < 8; ++j) o[j] = v[j] * partkv[tok0 + j];
        const size_t o0 = vt_off(tok0 >> 13, h, tok0 & (SEQ - 1), d), o1 = vt_off(tok0 >> 13, h, (tok0 & (SEQ - 1)) + 4, d);
        u32x2 w0, w1; w0.x = pk2(o[0], o[1]); w0.y = pk2(o[2], o[3]); w1.x = pk2(o[4], o[5]); w1.y = pk2(o[6], o[7]);
        *(u32x2*)(vt + o0) = w0; *(u32x2*)(vt + o1) = w1;
    }
};
struct EpiOut {
    const float* x; float* x1;
    DI float rowctx(int) const { return 1.f; }
    DI void operator()(int row, int col0, const float (&v)[8], float) const {
        const f32x4 a = *(const f32x4*)(x + (size_t)row * DM + col0), b = *(const f32x4*)(x + (size_t)row * DM + col0 + 4);
        *(f32x4*)(x1 + (size_t)row * DM + col0) = (f32x4){a.x + v[0], a.y + v[1], a.z + v[2], a.w + v[3]};
        *(f32x4*)(x1 + (size_t)row * DM + col0 + 4) = (f32x4){b.x + v[4], b.y + v[5], b.z + v[6], b.w + v[7]};
    }
};
struct EpiGlu {
    unsigned char* act; const float* bgu; int e, base;
    DI void operator()(int r, int f0, const float (&g)[8], const float (&u)[8]) const {
        float o[8];
#pragma unroll
        for (int j = 0; j < 8; ++j) { float gg = g[j] * W8_INV + bgu[(size_t)e * 2048 + f0 + j], uu = u[j] * W8_INV + bgu[(size_t)e * 2048 + 1024 + f0 + j];
            gg = fminf(gg, 7.f); uu = fminf(fmaxf(uu, -7.f), 7.f); const float glu = gg / (1.f + __expf(-1.702f * gg)); o[j] = (uu + 1.f) * glu; }
        u32x2 w; w.x = pk4_fp8(o[0], o[1], o[2], o[3]); w.y = pk4_fp8(o[4], o[5], o[6], o[7]); *(u32x2*)(act + (size_t)(base + r) * DFF + f0) = w;
    }
};
struct EpiDown {
    bf16_t* ys; const float* bd; const float* listg; int e, base, cnt;
    DI void operator()(int r, int c0, const float (&v)[8]) const {
        const float gw = r < cnt ? listg[(size_t)e * NTOK + r] : 0.f; float o[8];
#pragma unroll
        for (int j = 0; j < 8; ++j) o[j] = (v[j] * W8_INV + bd[(size_t)e * DM + c0 + j]) * gw;
        store8(ys + (size_t)(base + r) * DM + c0, o);
    }
};

template <class AF, class BF, class EF>
__global__ __launch_bounds__(256) void naive_gemm(int K, AF af, BF bf, EF ef) {
    __shared__ float As[16][68]; __shared__ float Bs[16][132];
    const int tid = threadIdx.x, ty = tid >> 4, tx = tid & 15, row0 = blockIdx.y * 64, col0 = blockIdx.x * 128;
    float acc[4][8];
#pragma unroll
    for (int i = 0; i < 4; ++i)
#pragma unroll
        for (int j = 0; j < 8; ++j) acc[i][j] = 0.f;
    for (int k0 = 0; k0 < K; k0 += 16) {
#pragma unroll
        for (int i = 0; i < 4; ++i) { const int idx = tid + i * 256, m = idx >> 4, k = idx & 15; As[k][m] = af(row0 + m, k0 + k); }
#pragma unroll
        for (int i = 0; i < 8; ++i) { const int idx = tid + i * 256, k = idx >> 7, n = idx & 127; Bs[k][n] = bf(k0 + k, col0 + n); }
        __syncthreads();
#pragma unroll
        for (int k = 0; k < 16; ++k) { float a[4], b[8];
#pragma unroll
            for (int i = 0; i < 4; ++i) a[i] = As[k][ty * 4 + i];
#pragma unroll
            for (int j = 0; j < 8; ++j) b[j] = Bs[k][tx * 8 + j];
#pragma unroll
            for (int i = 0; i < 4; ++i)
#pragma unroll
                for (int j = 0; j < 8; ++j) acc[i][j] += a[i] * b[j]; }
        __syncthreads();
    }
#pragma unroll
    for (int i = 0; i < 4; ++i) { const int row = row0 + ty * 4 + i; ef(row, col0 + tx * 8, acc[i], ef.rowctx(row)); }
}
struct ABf16 { const bf16_t* p; int ld; int pad; DI float operator()(int m, int k) const { return bf2f(p[(size_t)m * ld + k]); } };
struct BInproj { const float* w; DI float operator()(int k, int n) const { const int s = inproj_src_col(n); return s >= 0 ? w[(size_t)k * IN_W + s] : 0.f; } };
struct BUq { const float* w; const float* g; DI float operator()(int k, int n) const { return g[k] * w[(size_t)k * 768 + q_src_col(n)]; } };
struct BKn { const float* w; const float* g; DI float operator()(int k, int n) const { return g[k] * w[(size_t)k * 1024 + (n >> 6) * 128 + (n & 63)]; } };
struct AVw { const float* w; const float* g; DI float operator()(int m, int k) const { return g[k] * w[(size_t)k * 1024 + (m >> 6) * 128 + 64 + (m & 63)]; } };
struct BTok { const bf16_t* p; int ld; int pad; DI float operator()(int k, int n) const { return bf2f(p[(size_t)n * ld + k]); } };
struct BPlain { const float* w; int ld; int pad; DI float operator()(int k, int n) const { return w[(size_t)k * ld + n]; } };

__global__ __launch_bounds__(256) void naive_conv(const bf16_t* __restrict__ proj, const float* __restrict__ cw, const float* __restrict__ cb, float* __restrict__ xc) {
    const size_t idx = (size_t)blockIdx.x * 256 + threadIdx.x; const int tok = (int)(idx >> 10), ch = (int)(idx & 1023), t = tok & (SEQ - 1);
    float a = cb[ch];
#pragma unroll
    for (int k = 0; k < 4; ++k) { const int tt = t + k - 3; if (tt >= 0) a += cw[k * 1024 + ch] * bf2f(proj[(size_t)(tok + k - 3) * 1536 + 512 + ch]); }
    xc[idx] = silu(a);
}
__global__ __launch_bounds__(256) void naive_ssd(const float* __restrict__ xc, const float* __restrict__ dtr, const float* __restrict__ dt_bias, const float* __restrict__ a_log, const float* __restrict__ d_skip, float* __restrict__ y) {
    const int b = blockIdx.x >> 3, h = blockIdx.x & 7, g = h >> 2, p = threadIdx.x >> 2, nq = threadIdx.x & 3;
    const float a = -__expf(a_log[h]), dsk = d_skip[h], dtb = dt_bias[h];
    float st[32];
#pragma unroll
    for (int i = 0; i < 32; ++i) st[i] = 0.f;
    for (int t = 0; t < SEQ; ++t) {
        const size_t tok = (size_t)b * SEQ + t; const float* row = xc + tok * 1024;
        const float v = dtr[tok * 8 + h] + dtb; const float dtv = v > 20.f ? v : log1pf(__expf(v));
        const float dA = __expf(dtv * a), xv = row[h * 64 + p], xd = dtv * xv;
        const f32x4* Bp = (const f32x4*)(row + 512 + g * 128 + nq * 32); const f32x4* Cp = (const f32x4*)(row + 768 + g * 128 + nq * 32);
        float yy = 0.f;
#pragma unroll
        for (int i = 0; i < 8; ++i) { const f32x4 bv = Bp[i], cv = Cp[i];
            st[4 * i + 0] = st[4 * i + 0] * dA + xd * bv.x; yy += cv.x * st[4 * i + 0];
            st[4 * i + 1] = st[4 * i + 1] * dA + xd * bv.y; yy += cv.y * st[4 * i + 1];
            st[4 * i + 2] = st[4 * i + 2] * dA + xd * bv.z; yy += cv.z * st[4 * i + 2];
            st[4 * i + 3] = st[4 * i + 3] * dA + xd * bv.w; yy += cv.w * st[4 * i + 3]; }
        yy += __shfl_xor(yy, 1); yy += __shfl_xor(yy, 2);
        if (nq == 0) y[tok * 512 + h * 64 + p] = yy + dsk * xv;
    }
}
__global__ __launch_bounds__(256) void k_ssd_gate_norm(const float* __restrict__ y, const bf16_t* __restrict__ proj, const float* __restrict__ ng, bf16_t* __restrict__ ycat) {
    const int w = blockIdx.x * 4 + (threadIdx.x >> 6), lane = threadIdx.x & 63, tok = w >> 1, g = w & 1, c0 = g * 256 + 4 * lane;
    const f32x4 yv = *(const f32x4*)(y + (size_t)tok * 512 + c0); const u32x2 zz = *(const u32x2*)(proj + (size_t)tok * 1536 + c0);
    const float z0 = __uint_as_float(zz.x << 16), z1 = __uint_as_float(zz.x & 0xffff0000u), z2 = __uint_as_float(zz.y << 16), z3 = __uint_as_float(zz.y & 0xffff0000u);
    const float v0 = yv.x * silu(z0), v1 = yv.y * silu(z1), v2 = yv.z * silu(z2), v3 = yv.w * silu(z3);
    const float r = rsqrtf(wave_sum(v0 * v0 + v1 * v1 + v2 * v2 + v3 * v3) * (1.f / 256.f) + EPS);
    const f32x4 gg = *(const f32x4*)(ng + c0); u32x2 o; o.x = pk2(v0 * r * gg.x, v1 * r * gg.y); o.y = pk2(v2 * r * gg.z, v3 * r * gg.w);
    *(u32x2*)(ycat + (size_t)tok * DM + c0) = o;
}

__global__ __launch_bounds__(64) void naive_attn(const bf16_t* __restrict__ Q, const bf16_t* __restrict__ K, const bf16_t* __restrict__ VT, bf16_t* __restrict__ ycat) {
    const int bh = blockIdx.x >> 7, qblk = blockIdx.x & 127, b = bh >> 3, h = bh & 7, qi = qblk * 64 + threadIdx.x;
    float q[96], o[64];
#pragma unroll
    for (int dc = 0; dc < 12; ++dc) { float t[8]; load8(Q + qk_off(b, h, qi, dc), t);
#pragma unroll
        for (int j = 0; j < 8; ++j) q[dc * 8 + j] = t[j]; }
#pragma unroll
    for (int d = 0; d < 64; ++d) o[d] = 0.f;
    float m = -1e30f, l = 0.f;
    const int kmax = qblk * 64 + 63;
    for (int key = 0; key <= kmax; ++key) {
        float s = 0.f;
#pragma unroll
        for (int dc = 0; dc < 12; ++dc) { float t[8]; load8(K + qk_off(b, h, key, dc), t);
#pragma unroll
            for (int j = 0; j < 8; ++j) s += q[dc * 8 + j] * t[j]; }
        if (key <= qi) {
            const float mn = fmaxf(m, s), al = exp2f(m - mn), pp = exp2f(s - mn);
            l = l * al + pp; m = mn;
#pragma unroll
            for (int d = 0; d < 64; ++d) o[d] = o[d] * al + pp * bf2f(VT[vt_off(b, h, key, d)]);
        }
    }
    const float il = 1.f / l; const size_t tok = (size_t)b * SEQ + qi;
#pragma unroll
    for (int d = 0; d < 64; d += 8) { float t[8];
#pragma unroll
        for (int j = 0; j < 8; ++j) t[j] = o[d + j] * il;
        store8(ycat + tok * DM + 512 + h * 64 + d, t); }
}

__global__ __launch_bounds__(256) void k_router(const float* __restrict__ x1, const float* __restrict__ g, const float* __restrict__ wr, const float* __restrict__ br, bf16_t* __restrict__ h2,
                                                u32* __restrict__ cnt, int* __restrict__ list, float* __restrict__ listg, int* __restrict__ toke, int* __restrict__ tokp) {
    const int tok = blockIdx.x * 4 + (threadIdx.x >> 6), lane = threadIdx.x & 63;
    const f32x4* xr = (const f32x4*)(x1 + (size_t)tok * DM) + lane; f32x4 v[4]; float ss = 0.f;
#pragma unroll
    for (int j = 0; j < 4; ++j) { v[j] = xr[64 * j]; ss += v[j].x * v[j].x + v[j].y * v[j].y + v[j].z * v[j].z + v[j].w * v[j].w; }
    const float r = rsqrtf(wave_sum(ss) * (1.f / DM) + EPS);
    float lg[32];
#pragma unroll
    for (int e = 0; e < 32; ++e) lg[e] = 0.f;
#pragma unroll
    for (int j = 0; j < 4; ++j) { const f32x4 gg = ((const f32x4*)g)[lane + 64 * j]; const float hv[4] = {v[j].x * r * gg.x, v[j].y * r * gg.y, v[j].z * r * gg.z, v[j].w * r * gg.w};
        u32x2 w; w.x = pk2(hv[0], hv[1]); w.y = pk2(hv[2], hv[3]); *(u32x2*)(h2 + (size_t)tok * DM + 4 * (lane + 64 * j)) = w;
#pragma unroll
        for (int i = 0; i < 4; ++i) { const f32x4* wp = (const f32x4*)(wr + (size_t)(4 * (lane + 64 * j) + i) * NE);
#pragma unroll
            for (int e4 = 0; e4 < 8; ++e4) { const f32x4 ww = wp[e4]; lg[4 * e4] += hv[i] * ww.x; lg[4 * e4 + 1] += hv[i] * ww.y; lg[4 * e4 + 2] += hv[i] * ww.z; lg[4 * e4 + 3] += hv[i] * ww.w; } } }
#pragma unroll
    for (int e = 0; e < 32; ++e) lg[e] = wave_sum(lg[e]) + br[e];
    int sel[4]; float sv[4];
#pragma unroll
    for (int k = 0; k < 4; ++k) { float best = -3.0e38f; int bi = 0;
#pragma unroll
        for (int e = 0; e < 32; ++e) if (lg[e] > best) { best = lg[e]; bi = e; }
        sel[k] = bi; sv[k] = best;
#pragma unroll
        for (int e = 0; e < 32; ++e) if (e == bi) lg[e] = -3.0e38f; }
    const float e1 = __expf(sv[1] - sv[0]), e2 = __expf(sv[2] - sv[0]), e3 = __expf(sv[3] - sv[0]), inv = 1.f / (1.f + e1 + e2 + e3);
    const float gw[4] = {inv, e1 * inv, e2 * inv, e3 * inv};
    if (lane == 0) {
#pragma unroll
        for (int k = 0; k < 4; ++k) { const int e = sel[k]; const u32 p = atomicAdd(cnt + e, 1u); list[(size_t)e * NTOK + p] = tok; listg[(size_t)e * NTOK + p] = gw[k]; toke[tok * 4 + k] = e; tokp[tok * 4 + k] = (int)p; }
    }
}
__global__ __launch_bounds__(256) void k_combine(const float* __restrict__ x1, const bf16_t* __restrict__ ys, const u32* __restrict__ cnt, const int* __restrict__ toke, const int* __restrict__ tokp, const float* __restrict__ g, float* __restrict__ out) {
    const int tok = blockIdx.x * 4 + (threadIdx.x >> 6), lane = threadIdx.x & 63;
    int tiles = lane < 32 ? (int)((cnt[lane & 31] + 255) >> 8) : 0, incl = tiles;
#pragma unroll
    for (int o = 1; o < 32; o <<= 1) { const int t = __shfl_up(incl, o); if ((lane & 31) >= o) incl += t; }
    const int excl = (incl - tiles) << 8;
    f32x4 v[4];
#pragma unroll
    for (int j = 0; j < 4; ++j) v[j] = ((const f32x4*)(x1 + (size_t)tok * DM))[lane + 64 * j];
#pragma unroll
    for (int k = 0; k < 4; ++k) { const int e = toke[tok * 4 + k], p = tokp[tok * 4 + k]; const int srow = __shfl(excl, e) + p; const bf16_t* yr = ys + (size_t)srow * DM;
#pragma unroll
        for (int j = 0; j < 4; ++j) { const u32x2 w = *(const u32x2*)(yr + 4 * (lane + 64 * j));
            v[j].x += __uint_as_float(w.x << 16); v[j].y += __uint_as_float(w.x & 0xffff0000u); v[j].z += __uint_as_float(w.y << 16); v[j].w += __uint_as_float(w.y & 0xffff0000u); } }
    float ss = 0.f;
#pragma unroll
    for (int j = 0; j < 4; ++j) ss += v[j].x * v[j].x + v[j].y * v[j].y + v[j].z * v[j].z + v[j].w * v[j].w;
    const float r = rsqrtf(wave_sum(ss) * (1.f / DM) + EPS);
#pragma unroll
    for (int j = 0; j < 4; ++j) { const f32x4 gg = ((const f32x4*)g)[lane + 64 * j]; ((f32x4*)(out + (size_t)tok * DM))[lane + 64 * j] = (f32x4){v[j].x * r * gg.x, v[j].y * r * gg.y, v[j].z * r * gg.z, v[j].w * r * gg.w}; }
}


#define LAS __attribute__((address_space(3)))
#define GAS __attribute__((address_space(1)))
typedef short bf16x8 __attribute__((ext_vector_type(8)));
typedef int i32x4_t __attribute__((ext_vector_type(4)));
typedef int i32x8_t __attribute__((ext_vector_type(8)));
typedef GAS unsigned gu32;
#define RLX_AGENT __ATOMIC_RELAXED, __HIP_MEMORY_SCOPE_AGENT
namespace pg8 {
__device__ __forceinline__ const char* uni(const char* p) { const unsigned long long u = (unsigned long long)p; const unsigned lo = __builtin_amdgcn_readfirstlane((unsigned)u), hi = __builtin_amdgcn_readfirstlane((unsigned)(u >> 32));
    return (const char*)(((unsigned long long)hi << 32) | lo); }
constexpr int BM = 256, BK = 64, HALF = 128, HTB = HALF * BK * 2  , STAGE_BYTES = 8 * HTB;
__host__ __device__ __forceinline__ int lds_byte(int r, int c) { const int st = (r >> 4) * 2 + (c >> 5), rr = r & 15, cc = c & 31, ob = rr * 64 + cc * 2; return st * 1024 + (ob ^ (((ob >> 9) & 1) << 5)); }
__host__ __device__ __forceinline__ void stage_rc(int b, int& R, int& C) { const int st = b / 1024, sb = b % 1024, swz = sb ^ (((sb >> 9) & 1) << 5); R = (st >> 1) * 16 + swz / 64; C = (st & 1) * 32 + (swz % 64) / 2; }
__host__ __device__ __forceinline__ int perm32(int rho) { const int n = rho >> 4, i = rho & 15; return 8 * (i >> 2) + 4 * n + (i & 3); }

struct Unit { int pm, pn; const char* A; const char* B; int e, base, cnt, pad; };

template <bool FP8 = false, class Epi, class Sched>
__device__ __forceinline__ void gemm_phase(LAS unsigned char* lds, const int K_, const Sched& S, const Epi& E) {
    int K = K_; asm volatile("" : "+s"(K));
    const int tid = threadIdx.x, wid = __builtin_amdgcn_readfirstlane(tid >> 6), lane = tid & 63, wr = wid >> 2, wc = wid & 3, fr = lane & 15, fq = lane >> 4;
    const int nt = K / BK;
    int RA[2], CA[2]; unsigned voffB[2];
#pragma unroll
    for (int i = 0; i < 2; ++i) { int R, C; stage_rc(tid * 16 + i * 8192, R, C); const int Rb = (R & ~31) + perm32(R & 31); RA[i] = R; CA[i] = C; voffB[i] = (unsigned)(Rb * K + C) * 2u; }
    const size_t kstep = (size_t)(BK * 2);
    const size_t hstepB = (size_t)HALF * K * 2;
    const unsigned ldsw = (unsigned)wid * 1024u;
    const int aoff = lds_byte(wr * 64 + fr, fq * 8), boff = lds_byte(wc * 32 + fr, fq * 8);
#define PG8_SA(b, h) (((b) * 2 + (h)) * HTB)
#define PG8_SB(b, h) ((4 + (b) * 2 + (h)) * HTB)
#define PG8_STAGE(bufoff, gbase, v0, v1) do { \
        __builtin_amdgcn_global_load_lds((const unsigned*)((const char*)(gbase) + (v0)), (LAS unsigned*)(lds + (bufoff) + ldsw), 16, 0, 0); \
        __builtin_amdgcn_global_load_lds((const unsigned*)((const char*)(gbase) + (v1)), (LAS unsigned*)(lds + (bufoff) + ldsw + 8192), 16, 0, 0); } while (0)
#define PG8_STAGEB(bufoff, gbase) PG8_STAGE(bufoff, gbase, voffB[0], voffB[1])
#define PG8_LD8(p) __builtin_shufflevector(*(const LAS i32x4_t*)(p), *(const LAS i32x4_t*)((p) + 1024), 0, 1, 2, 3, 4, 5, 6, 7)
#define PG8_LDA(dst, b, h) do { if constexpr (FP8) { _Pragma("unroll") for (int m = 0; m < 4; ++m) dst##8[m] = PG8_LD8(lds + PG8_SA(b, h) + aoff + m * 2048); } \
        else { _Pragma("unroll") for (int m = 0; m < 4; ++m) _Pragma("unroll") for (int k = 0; k < 2; ++k) dst[m][k] = *(const LAS bf16x8*)(lds + PG8_SA(b, h) + aoff + m * 2048 + k * 1024); } } while (0)
#define PG8_LDB(dst, b, h) do { if constexpr (FP8) { _Pragma("unroll") for (int n = 0; n < 2; ++n) dst##8[n] = PG8_LD8(lds + PG8_SB(b, h) + boff + n * 2048); } \
        else { _Pragma("unroll") for (int n = 0; n < 2; ++n) _Pragma("unroll") for (int k = 0; k < 2; ++k) dst[n][k] = *(const LAS bf16x8*)(lds + PG8_SB(b, h) + boff + n * 2048 + k * 1024); } } while (0)
#define PG8_MMA(ai, bj, At, Bt) do { __builtin_amdgcn_s_setprio(1); if constexpr (FP8) { _Pragma("unroll") for (int m = 0; m < 4; ++m) _Pragma("unroll") for (int n = 0; n < 2; ++n) \
        acc[ai][bj][m][n] = __builtin_amdgcn_mfma_scale_f32_16x16x128_f8f6f4(Bt##8[n], At##8[m], acc[ai][bj][m][n], 0, 0, 0, 0x7f7f7f7f, 0, 0x7f7f7f7f); } \
      else { _Pragma("unroll") for (int m = 0; m < 4; ++m) _Pragma("unroll") for (int n = 0; n < 2; ++n) _Pragma("unroll") for (int k = 0; k < 2; ++k) \
        acc[ai][bj][m][n] = __builtin_amdgcn_mfma_f32_16x16x32_bf16(Bt[n][k], At[m][k], acc[ai][bj][m][n], 0, 0, 0); } __builtin_amdgcn_s_setprio(0); } while (0)
#define PG8_WAIT_V(n) asm volatile("s_waitcnt vmcnt(" #n ")" ::: "memory")
#define PG8_WAIT_L(n) asm volatile("s_waitcnt lgkmcnt(" #n ")" ::: "memory")
#define PG8_BAR __builtin_amdgcn_s_barrier()
#define PG8_SCHED __builtin_amdgcn_sched_barrier(0)
    Unit cur, nxt; int ui = 0;
    if (!S.next(0, cur)) return;
    f32x4 acc[2][2][4][2];
#pragma unroll
    for (int a = 0; a < 2; ++a)
#pragma unroll
        for (int b = 0; b < 2; ++b)
#pragma unroll
            for (int m = 0; m < 4; ++m)
#pragma unroll
                for (int n = 0; n < 2; ++n) acc[a][b][m][n] = (f32x4){0.f, 0.f, 0.f, 0.f};
    bf16x8 At[4][2], B0[2][2], B1[2][2]; i32x8_t At8[4], B08[2], B18[2];
    unsigned vc[2][2], vn[2][2];
#pragma unroll
    for (int h = 0; h < 2; ++h)
#pragma unroll
        for (int i = 0; i < 2; ++i) { vc[h][i] = S.arow(cur, RA[i] + h * HALF) + (unsigned)CA[i] * 2u; vn[h][i] = vc[h][i]; }
    const char* cA = cur.A; const char* cB = cur.B;
    PG8_STAGEB(PG8_SB(0, 0), cB); PG8_STAGEB(PG8_SB(0, 1), cB + hstepB); PG8_STAGE(PG8_SA(0, 0), cA, vc[0][0], vc[0][1]); PG8_STAGE(PG8_SA(0, 1), cA, vc[1][0], vc[1][1]);
    if (wr == 1) PG8_BAR;
    PG8_WAIT_V(2); PG8_BAR;
    PG8_STAGEB(PG8_SB(1, 0), cB + kstep); PG8_STAGE(PG8_SA(1, 0), cA + kstep, vc[0][0], vc[0][1]); PG8_STAGEB(PG8_SB(1, 1), cB + hstepB + kstep);
    PG8_WAIT_V(6); PG8_BAR;
#pragma unroll 1
    for (;;) {
        const bool has_next = S.next(ui + 1, nxt);
        const char* nA = has_next ? nxt.A : cA; const char* nB = has_next ? nxt.B : cB;
        if (Sched::GATHER) { if (has_next) {
#pragma unroll
            for (int h = 0; h < 2; ++h)
#pragma unroll
                for (int i = 0; i < 2; ++i) vn[h][i] = S.arow(nxt, RA[i] + h * HALF) + (unsigned)CA[i] * 2u; } }
#pragma unroll 1
        for (int t = 0; t < nt; t += 2) {
            const bool last = (t == nt - 2);
            const char* a1 = uni(cA + (size_t)(t + 1) * kstep);
            const char* a2 = uni(last ? nA : cA + (size_t)(t + 2) * kstep); const char* b2 = uni(last ? nB : cB + (size_t)(t + 2) * kstep);
            const char* a3 = a2 + kstep; const char* b3 = b2 + kstep;
            unsigned v2[2][2];
#pragma unroll
            for (int h = 0; h < 2; ++h)
#pragma unroll
                for (int i = 0; i < 2; ++i) v2[h][i] = (Sched::GATHER && last) ? vn[h][i] : vc[h][i];
            PG8_LDB(B0, 0, 0); PG8_LDB(B1, 0, 1); PG8_SCHED; PG8_LDA(At, 0, 0); PG8_STAGE(PG8_SA(1, 1), a1, vc[1][0], vc[1][1]);
            PG8_WAIT_V(8); PG8_WAIT_L(0); PG8_BAR; PG8_MMA(0, 0, At, B0); PG8_MMA(0, 1, At, B1); PG8_BAR; PG8_SCHED;
            PG8_LDA(At, 0, 1); PG8_STAGEB(PG8_SB(0, 0), b2); PG8_STAGEB(PG8_SB(0, 1), b2 + hstepB); PG8_STAGE(PG8_SA(0, 0), a2, v2[0][0], v2[0][1]);
            PG8_WAIT_V(8); PG8_WAIT_L(0); PG8_BAR; PG8_MMA(1, 0, At, B0); PG8_MMA(1, 1, At, B1); PG8_BAR; PG8_SCHED;
            PG8_LDB(B0, 1, 0); PG8_LDB(B1, 1, 1); PG8_SCHED; PG8_LDA(At, 1, 0); PG8_STAGE(PG8_SA(0, 1), a2, v2[1][0], v2[1][1]);
            PG8_WAIT_V(8); PG8_WAIT_L(0); PG8_BAR; PG8_MMA(0, 0, At, B0); PG8_MMA(0, 1, At, B1); PG8_BAR; PG8_SCHED;
            PG8_LDA(At, 1, 1); PG8_STAGEB(PG8_SB(1, 0), b3); PG8_STAGEB(PG8_SB(1, 1), b3 + hstepB); PG8_STAGE(PG8_SA(1, 0), a3, v2[0][0], v2[0][1]);
            PG8_WAIT_V(8); PG8_WAIT_L(0); PG8_BAR; PG8_MMA(1, 0, At, B0); PG8_MMA(1, 1, At, B1); PG8_BAR; PG8_SCHED;
        }
        if (wr == 0) PG8_BAR;
        E(acc, cur, wr, wc, fr, fq);
        if (!has_next) break;
#pragma unroll
        for (int a = 0; a < 2; ++a)
#pragma unroll
            for (int b = 0; b < 2; ++b)
#pragma unroll
                for (int m = 0; m < 4; ++m)
#pragma unroll
                    for (int n = 0; n < 2; ++n) acc[a][b][m][n] = (f32x4){0.f, 0.f, 0.f, 0.f};
        cur = nxt; cA = nA; cB = nB; ++ui;
#pragma unroll
        for (int h = 0; h < 2; ++h)
#pragma unroll
            for (int i = 0; i < 2; ++i) vc[h][i] = vn[h][i];
        if (wr == 1) PG8_BAR;
    }
    PG8_WAIT_V(0);
    PG8_BAR;
#undef PG8_SA
#undef PG8_SB
#undef PG8_STAGE
#undef PG8_STAGEB
#undef PG8_LDA
#undef PG8_LDB
#undef PG8_MMA
#undef PG8_LD8
#undef PG8_WAIT_V
#undef PG8_WAIT_L
#undef PG8_BAR
#undef PG8_SCHED
}

template <class EF> struct EpiRows {
    EF ef;
    __device__ __forceinline__ void operator()(const f32x4 (&acc)[2][2][4][2], const Unit& u, int wr, int wc, int fr, int fq) const {
        const int row0 = u.pm * BM + wr * 64 + fr, col0 = u.pn * BM + wc * 32 + 8 * fq;
#pragma unroll
        for (int ai = 0; ai < 2; ++ai)
#pragma unroll
            for (int m = 0; m < 4; ++m) { const int row = row0 + ai * HALF + m * 16; const float ctx = ef.rowctx(row);
#pragma unroll
                for (int bj = 0; bj < 2; ++bj) { const f32x4 a = acc[ai][bj][m][0], b = acc[ai][bj][m][1]; const float v[8] = {a[0], a[1], a[2], a[3], b[0], b[1], b[2], b[3]}; ef(row, col0 + bj * HALF, v, ctx); } }
    }
};
struct GridOrder {
    const char* A; const char* Bt; int K, nM, nN, G, vcu, pad;
    static constexpr bool GATHER = false;
    __device__ __forceinline__ bool next(int i, Unit& u) const { const int L = i * G + vcu; if (L >= nM * nN) return false; u.pm = L / nN; u.pn = L - u.pm * nN;
        u.A = A + (size_t)u.pm * BM * K * 2; u.B = Bt + (size_t)u.pn * BM * K * 2; u.e = 0; u.base = 0; u.cnt = 0; u.pad = 0; return true; }
    __device__ __forceinline__ unsigned arow(const Unit&, int R) const { return (unsigned)(R * K) * 2u; }
};
}

#define XB_TMO      128
#define XB_XCNT(j)  (256  + 64 * (j))
#define XB_XSUB(j)  (1280 + 64 * (j))
#define XB_XGEN(j)  (2304 + 64 * (j))
#define XB_TOP      3328
#define XB_TOPGEN   3392
#define XCD_BAR_WORDS 3456
#define XB_SPIN_CAP (1u << 18)
__device__ __forceinline__ unsigned xb_ld(unsigned* p)              { return __hip_atomic_load(p, __ATOMIC_RELAXED, __HIP_MEMORY_SCOPE_AGENT); }
__device__ __forceinline__ unsigned xb_add(unsigned* p, unsigned v) { return __hip_atomic_fetch_add(p, v, __ATOMIC_RELAXED, __HIP_MEMORY_SCOPE_AGENT); }
__device__ __forceinline__ unsigned xb_xcc_id() { return (unsigned)__builtin_amdgcn_s_getreg((3 << 11) | 20) & 0xFu; }
#define XB_SPIN(cond, bar) do { unsigned _sp = 0; while (cond) { __builtin_amdgcn_s_sleep(1); \
    if ((++_sp & 255u) == 0u) { if (xb_ld(&(bar)[XB_TMO])) break; if (_sp > XB_SPIN_CAP) { atomicAdd(&(bar)[XB_TMO], 1u); break; } } } } while (0)
struct XcdBarrier { unsigned* bar; unsigned x; volatile LAS unsigned* st; };
__device__ __forceinline__ XcdBarrier xcd_barrier_post(unsigned* bar, volatile LAS unsigned* st) {
    XcdBarrier b; b.bar = bar; b.x = xb_xcc_id(); b.st = st;
    if (threadIdx.x == 0) (void)xb_add(&bar[XB_XCNT(b.x)], 1u);
    return b;
}
__device__ __forceinline__ void xcd_barrier_complete(unsigned* bar, unsigned x, unsigned& nloc, unsigned& nx) {
    const unsigned G = gridDim.x * gridDim.y * gridDim.z;
    unsigned sum, cnt, mine, sp = 0u;
    for (;;) {
        sum = 0u; cnt = 0u; mine = 0u;
#pragma unroll
        for (unsigned j = 0; j < 16; ++j) { const unsigned c = xb_ld(&bar[XB_XCNT(j)]); sum += c; cnt += (c > 0u) ? 1u : 0u; mine = (j == x) ? c : mine; }
        if (sum == G) break;
        __builtin_amdgcn_s_sleep(1);
        if ((++sp & 255u) == 0u) { if (xb_ld(&bar[XB_TMO])) break; if (sp > XB_SPIN_CAP) { atomicAdd(&bar[XB_TMO], 1u); break; } }
    }
    nloc = mine > 0u ? mine : 1u; nx = cnt > 0u ? cnt : 1u;
}
__device__ __forceinline__ void xcd_barrier(const XcdBarrier& b) {
    asm volatile("s_waitcnt vmcnt(0)" ::: "memory");
    __syncthreads();
    if (threadIdx.x == 0) {
        unsigned* bar = b.bar;
        __builtin_amdgcn_s_waitcnt(0);
        unsigned nloc = b.st[0], nx = b.st[1];
        if (nloc == 0u) { xcd_barrier_complete(bar, b.x, nloc, nx); b.st[0] = nloc; b.st[1] = nx; }
        const unsigned old = xb_add(&bar[XB_XSUB(b.x)], 1u);
        const unsigned gen = old / nloc;
        if (old + 1u == (gen + 1u) * nloc) {
            __builtin_amdgcn_fence(__ATOMIC_RELEASE, "agent");
            asm volatile("s_waitcnt vmcnt(0)" ::: "memory");
            const unsigned og = xb_add(&bar[XB_TOP], 1u);
            const unsigned tg = og / nx;
            if (og + 1u == (tg + 1u) * nx) xb_add(&bar[XB_TOPGEN], 1u);
            else XB_SPIN(xb_ld(&bar[XB_TOPGEN]) == tg, bar);
            __builtin_amdgcn_fence(__ATOMIC_ACQUIRE, "agent");
            xb_add(&bar[XB_XGEN(b.x)], 1u);
            asm volatile("s_waitcnt vmcnt(0)" ::: "memory");
        } else {
            XB_SPIN(xb_ld(&bar[XB_XGEN(b.x)]) == gen, bar);
            __builtin_amdgcn_fence(__ATOMIC_ACQUIRE, "agent");
            asm volatile("s_waitcnt vmcnt(0)" ::: "memory");
        }
    }
    __syncthreads();
}

constexpr int NWAVES = 8, NTHR = 512;
constexpr int RING_BYTES = 147456, LDSCTL_OFF = RING_BYTES, MISC_OFF = LDSCTL_OFF + 320, LDS_BYTES = 163840;
constexpr int CW_BAR = 4096;
constexpr size_t WS_WIN = 4 * MiB, WS_WUQ = 8 * MiB, WS_WKN = 9 * MiB, WS_WV = 9 * MiB + 512 * 1024, WS_WOUT = 10 * MiB, WS_WGU = 16 * MiB, WS_WDN = 144 * MiB;

struct Args { const void* in[23]; float* out; unsigned char* ws; int ph_lo, ph_hi; };

template <class SrcMap>
__device__ __forceinline__ void p0_tile(const float* __restrict__ W, int ldw, int K, const float* __restrict__ gk, bf16_t* __restrict__ WT, int k0, int n0, const SrcMap& sm, int lane) {
    const int src = sm(n0 + lane);
    float v[64];
    if (src >= 0) {
#pragma unroll
        for (int i = 0; i < 64; ++i) v[i] = W[(size_t)(k0 + i) * ldw + src];
        if (gk) {
#pragma unroll
            for (int i = 0; i < 64; ++i) v[i] *= gk[k0 + i];
        }
    } else {
#pragma unroll
        for (int i = 0; i < 64; ++i) v[i] = 0.f;
    }
    bf16_t* o = WT + (size_t)(n0 + lane) * K + k0;
#pragma unroll
    for (int i = 0; i < 8; ++i) { u32x4 w; w.x = pk2(v[8 * i], v[8 * i + 1]); w.y = pk2(v[8 * i + 2], v[8 * i + 3]); w.z = pk2(v[8 * i + 4], v[8 * i + 5]); w.w = pk2(v[8 * i + 6], v[8 * i + 7]); *(u32x4*)(o + 8 * i) = w; }
}
template <class SrcMap>
__device__ __forceinline__ void p0_tile8(const float* __restrict__ W, int ldw, int K, unsigned char* __restrict__ WT, int k0, int n0, const SrcMap& sm, int lane) {
    const int src = sm(n0 + lane);
    float v[64];
#pragma unroll
    for (int i = 0; i < 64; ++i) v[i] = W[(size_t)(k0 + i) * ldw + src] * W8_SCALE;
    unsigned char* o = WT + (size_t)(n0 + lane) * K + k0;
#pragma unroll
    for (int i = 0; i < 4; ++i) { u32x4 w; w.x = pk4_fp8(v[16 * i], v[16 * i + 1], v[16 * i + 2], v[16 * i + 3]); w.y = pk4_fp8(v[16 * i + 4], v[16 * i + 5], v[16 * i + 6], v[16 * i + 7]);
        w.z = pk4_fp8(v[16 * i + 8], v[16 * i + 9], v[16 * i + 10], v[16 * i + 11]); w.w = pk4_fp8(v[16 * i + 12], v[16 * i + 13], v[16 * i + 14], v[16 * i + 15]); *(u32x4*)(o + 16 * i) = w; }
}
struct MapIn { __device__ __forceinline__ int operator()(int c) const { return inproj_src_col(c); } };
struct MapQ { __device__ __forceinline__ int operator()(int c) const { return q_src_col(c); } };
struct MapKn { __device__ __forceinline__ int operator()(int c) const { return (c >> 6) * 128 + (c & 63); } };
struct MapV { __device__ __forceinline__ int operator()(int c) const { return (c >> 6) * 128 + 64 + (c & 63); } };
struct MapId { __device__ __forceinline__ int operator()(int c) const { return c; } };
struct MapGU { __device__ __forceinline__ int operator()(int c) const { const int t = c >> 8, r = c & 255; return r < 128 ? 128 * t + r : 1024 + 128 * t + (r - 128); } };

namespace pg8 {
struct EpiColsVt {
    bf16_t* vt; const float* partkv;
    __device__ __forceinline__ void operator()(const f32x4 (&acc)[2][2][4][2], const Unit& u, int wr, int wc, int fr, int fq) const {
        const int row0 = u.pm * BM + wr * 64 + fr, col0 = u.pn * BM + wc * 32 + 8 * fq;
#pragma unroll
        for (int bj = 0; bj < 2; ++bj) {
            const int tok0 = col0 + bj * HALF, b = tok0 >> 13, s = tok0 & (SEQ - 1), sl = s & 63;
            const unsigned tbase = (unsigned)(((b * NH * 128 + (s >> 6)) * 8 + 2 * (sl >> 4)) * 512 + 4 * ((sl >> 3) & 1));
            const f32x4 s0 = *(const f32x4*)(partkv + tok0), s1 = *(const f32x4*)(partkv + tok0 + 4);
#pragma unroll
            for (int ai = 0; ai < 2; ++ai)
#pragma unroll
                for (int m = 0; m < 4; ++m) { const int row = row0 + ai * HALF + m * 16, h = row >> 6, d = row & 63;
                    const f32x4 a = acc[ai][bj][m][0], bb = acc[ai][bj][m][1]; const unsigned o0 = tbase + (unsigned)h * 524288u + (unsigned)d * 8u;
                    u32x2 w0, w1; w0.x = pk2(a[0] * s0[0], a[1] * s0[1]); w0.y = pk2(a[2] * s0[2], a[3] * s0[3]); w1.x = pk2(bb[0] * s1[0], bb[1] * s1[1]); w1.y = pk2(bb[2] * s1[2], bb[3] * s1[3]);
                    *(u32x2*)(vt + o0) = w0; *(u32x2*)(vt + o0 + 512) = w1; }
            asm volatile("" ::: "memory");
        }
    }
};
struct EpiMoeGlu {
    unsigned char* act; const float* bgu;
    __device__ __forceinline__ void operator()(const f32x4 (&acc)[2][2][4][2], const Unit& u, int wr, int wc, int fr, int fq) const {
        const EpiGlu E{act, bgu, u.e, u.base}; const int r0 = u.pm * BM + wr * 64 + fr, f0 = u.pn * HALF + wc * 32 + 8 * fq;
#pragma unroll
        for (int ai = 0; ai < 2; ++ai)
#pragma unroll
            for (int m = 0; m < 4; ++m) { const f32x4 g0 = acc[ai][0][m][0], g1 = acc[ai][0][m][1], u0 = acc[ai][1][m][0], u1 = acc[ai][1][m][1];
                const float g[8] = {g0[0], g0[1], g0[2], g0[3], g1[0], g1[1], g1[2], g1[3]}, uu[8] = {u0[0], u0[1], u0[2], u0[3], u1[0], u1[1], u1[2], u1[3]};
                E(r0 + ai * HALF + m * 16, f0, g, uu); }
    }
};
struct EpiMoeDown {
    bf16_t* ys; const float* bd; const float* listg;
    __device__ __forceinline__ void operator()(const f32x4 (&acc)[2][2][4][2], const Unit& u, int wr, int wc, int fr, int fq) const {
        const EpiDown E{ys, bd, listg, u.e, u.base, u.cnt}; const int r0 = u.pm * BM + wr * 64 + fr, c0 = u.pn * BM + wc * 32 + 8 * fq;
#pragma unroll
        for (int ai = 0; ai < 2; ++ai)
#pragma unroll
            for (int m = 0; m < 4; ++m)
#pragma unroll
                for (int bj = 0; bj < 2; ++bj) { const f32x4 a = acc[ai][bj][m][0], b = acc[ai][bj][m][1]; const float v[8] = {a[0], a[1], a[2], a[3], b[0], b[1], b[2], b[3]}; E(r0 + ai * HALF + m * 16, c0 + bj * HALF, v); }
    }
};
struct EpiInprojMfma {
    EpiInproj ef; float* scaleq; float* scalekv; LAS float* P;
    __device__ __forceinline__ void operator()(const f32x4 (&acc)[2][2][4][2], const Unit& u, int wr, int wc, int fr, int fq) const {
        const int row0 = u.pm * BM + wr * 64 + fr, col0 = u.pn * BM + wc * 32 + 8 * fq;
#pragma unroll
        for (int ai = 0; ai < 2; ++ai)
#pragma unroll
            for (int m = 0; m < 4; ++m) { const int row = row0 + ai * HALF + m * 16;
#pragma unroll
                for (int bj = 0; bj < 2; ++bj) { const f32x4 a = acc[ai][bj][m][0], b = acc[ai][bj][m][1]; const float v[8] = {a[0], a[1], a[2], a[3], b[0], b[1], b[2], b[3]}; ef(row, col0 + bj * HALF, v, 1.f); } }
        if (u.pn >= 6) {
            const bool isq = (u.pn == 6);
#pragma unroll
            for (int ai = 0; ai < 2; ++ai)
#pragma unroll
                for (int m = 0; m < 4; ++m) { float s = 0.f;
#pragma unroll
                    for (int n = 0; n < 2; ++n) { const f32x4 x = acc[ai][0][m][n]; s += (x[0] * x[0] + x[1] * x[1]) + (x[2] * x[2] + x[3] * x[3]); }
                    if (isq) {
#pragma unroll
                        for (int n = 0; n < 2; ++n) { const f32x4 x = acc[ai][1][m][n]; s += (x[0] * x[0] + x[1] * x[1]) + (x[2] * x[2] + x[3] * x[3]); } }
                    s += __shfl_xor(s, 16); s += __shfl_xor(s, 32);
                    if (fq == 0) P[(ai * HALF + wr * 64 + m * 16 + fr) * 4 + wc] = s; }
            asm volatile("s_waitcnt lgkmcnt(0)" ::: "memory"); __builtin_amdgcn_s_barrier(); asm volatile("" ::: "memory");
            const int t = threadIdx.x;
            if (t < 256) { const f32x4 p = *(const LAS f32x4*)(P + t * 4); const float sum = (p[0] + p[1]) + (p[2] + p[3]);
                if (isq) scaleq[u.pm * BM + t] = rsqrtf(sum * (1.f / 256.f) + EPS); else scalekv[u.pm * BM + t] = rsqrtf(sum * (1.f / 128.f) + EPS); }
            asm volatile("s_waitcnt lgkmcnt(0)" ::: "memory"); __builtin_amdgcn_s_barrier(); asm volatile("" ::: "memory");
        }
    }
};
struct GridOrderRot {
    const char* A; const char* Bt; int K, nM, nN, G, vcu, rot;
    static constexpr bool GATHER = false;
    __device__ __forceinline__ bool next(int i, Unit& u) const { int w = vcu - rot; if (w < 0) w += G; const int L = i * G + w; if (L >= nM * nN) return false; u.pm = L / nN; u.pn = L - u.pm * nN;
        u.A = A + (size_t)u.pm * BM * K * 2; u.B = Bt + (size_t)u.pn * BM * K * 2; u.e = 0; u.base = 0; u.cnt = 0; u.pad = 0; return true; }
    __device__ __forceinline__ unsigned arow(const Unit&, int R) const { return (unsigned)(R * K) * 2u; }
};
template <bool GATH> struct MoeOrder {
    const char* A; const char* Bt; const u32* cnt; const int* list; int K, nN, nfull, G, vcu, pad;
    static constexpr bool GATHER = GATH;
    __device__ __forceinline__ bool next(int i, Unit& u) const {
        const int L = i * G + vcu, mt = L / nN; int acc = 0, e = 0, c = 0;
        for (; e < NE; ++e) { c = (int)cnt[e * 64]; const int t = (c + 255) >> 8; if (mt < acc + t) break; acc += t; }
        if (e >= NE) return false;
        u.e = e; u.base = acc << 8; u.cnt = c; u.pm = mt - acc; u.pn = L - mt * nN; u.pad = 0;
        u.A = GATH ? A : A + (size_t)(u.base + u.pm * BM) * K * 2; u.B = Bt + ((size_t)e * nfull + (size_t)u.pn * BM) * K * 2; return true;
    }
    __device__ __forceinline__ unsigned arow(const Unit& u, int R) const {
        if (!GATH) return (unsigned)(R * K) * 2u;
        const int r = u.pm * BM + R; const int tok = list[(size_t)u.e * NTOK + (r < u.cnt ? r : 0)]; return (unsigned)tok * (unsigned)K * 2u;
    }
};
}

namespace g8 {
using pg8::lds_byte; using pg8::stage_rc; using pg8::perm32; using pg8::Unit; using pg8::uni;
constexpr int BUF = 49152, OFF_B = 16384, HTB = 16384;
template <class Epi, class Sched>
__device__ __forceinline__ void gemm_phase(LAS unsigned char* lds, const int KB_, const Sched& S, const Epi& E) {
    int KB = KB_; asm volatile("" : "+s"(KB));
    const int tid = threadIdx.x, wid = __builtin_amdgcn_readfirstlane(tid >> 6), lane = tid & 63, wr = wid >> 2, wc = wid & 3, fr = lane & 15, fq = lane >> 4;
    const int nt = KB / 128;
    unsigned voffB[2];
#pragma unroll
    for (int i = 0; i < 2; ++i) { int R, C; stage_rc(tid * 16 + i * 8192, R, C); const int Rb = (R & ~31) + perm32(R & 31); voffB[i] = (unsigned)(Rb * KB + C * 2); }
#define G8_AOFF(dst, u_) do { _Pragma("unroll") for (int i_ = 0; i_ < 2; ++i_) { int R_, C_; stage_rc((int)threadIdx.x * 16 + i_ * 8192, R_, C_); dst[i_] = S.arow(u_, R_) + (unsigned)(C_ * 2); } } while (0)
    const unsigned ldsw = (unsigned)wid * 1024u; const size_t hstepB = (size_t)128 * KB;
    const int aoff = lds_byte(wr * 64 + fr, fq * 8), boff = lds_byte(wc * 32 + fr, fq * 8);
#define G8_GLDS(dst, src) __builtin_amdgcn_global_load_lds((const unsigned*)(src), (LAS unsigned*)(lds + (dst)), 16, 0, 0)
#define G8_STAGE(bsel, a, va0, va1, bb, kt) do {   const char* a_ = uni((a) + (size_t)(kt) * 128); const char* b_ = uni((bb) + (size_t)(kt) * 128); \
        G8_GLDS((bsel) * BUF + ldsw, a_ + (va0)); G8_GLDS((bsel) * BUF + ldsw + 8192, a_ + (va1)); \
        G8_GLDS((bsel) * BUF + OFF_B + ldsw, b_ + voffB[0]); G8_GLDS((bsel) * BUF + OFF_B + ldsw + 8192, b_ + voffB[1]); \
        G8_GLDS((bsel) * BUF + OFF_B + HTB + ldsw, b_ + hstepB + voffB[0]); G8_GLDS((bsel) * BUF + OFF_B + HTB + ldsw + 8192, b_ + hstepB + voffB[1]); } while (0)
#define G8_LD8(p) __builtin_shufflevector(*(const LAS i32x4_t*)(p), *(const LAS i32x4_t*)((p) + 1024), 0, 1, 2, 3, 4, 5, 6, 7)
    Unit cur, nxt; int ui = 0;
    if (!S.next(0, cur)) return;
    f32x4 acc[2][4][2];
#pragma unroll
    for (int b = 0; b < 2; ++b)
#pragma unroll
        for (int m = 0; m < 4; ++m)
#pragma unroll
            for (int n = 0; n < 2; ++n) acc[b][m][n] = (f32x4){0.f, 0.f, 0.f, 0.f};
    unsigned vc[2];
#define G8_VPARK() ({ int tp_ = threadIdx.x; asm volatile("" : "+v"(tp_)); (LAS unsigned*)(lds + LDSCTL_OFF + 1024) + tp_ * 2; })
    G8_AOFF(vc, cur);
    i32x8_t Ax[4], Bx[2][2], Ay[4], By[2][2];
#define G8_READ(A_, B_, bo) do { _Pragma("unroll") for (int n_ = 0; n_ < 2; ++n_) { B_[0][n_] = G8_LD8(lds + (bo) + OFF_B + boff + n_ * 2048); B_[1][n_] = G8_LD8(lds + (bo) + OFF_B + HTB + boff + n_ * 2048); } \
        _Pragma("unroll") for (int m_ = 0; m_ < 4; ++m_) A_[m_] = G8_LD8(lds + (bo) + aoff + m_ * 2048); } while (0)
#define G8_MF(A_, B_, b_, m_, n_) acc[b_][m_][n_] = __builtin_amdgcn_mfma_scale_f32_16x16x128_f8f6f4(B_[b_][n_], A_[m_], acc[b_][m_][n_], 0, 0, 0, 0x7f7f7f7f, 0, 0x7f7f7f7f)
#define G8_SB __builtin_amdgcn_sched_barrier(0)
#define G8_STEP(AC, BC, AL, BL, bc, bl, sa, v0, v1, sb, kt) do { \
        asm volatile("s_waitcnt vmcnt(6) lgkmcnt(0)" ::: "memory"); __builtin_amdgcn_s_barrier(); asm volatile("" ::: "memory"); G8_SB; \
        G8_READ(AL, BL, bl); G8_SB; \
        const char* a_ = uni((sa) + (size_t)(kt) * 128); const char* b_ = uni((sb) + (size_t)(kt) * 128); \
        __builtin_amdgcn_s_setprio(1); \
        G8_MF(AC, BC, 0, 0, 0); G8_MF(AC, BC, 0, 0, 1); G8_SB; G8_GLDS((bc) + ldsw, a_ + (v0)); G8_SB; \
        G8_MF(AC, BC, 0, 1, 0); G8_MF(AC, BC, 0, 1, 1); G8_SB; G8_GLDS((bc) + ldsw + 8192, a_ + (v1)); G8_SB; \
        G8_MF(AC, BC, 0, 2, 0); G8_MF(AC, BC, 0, 2, 1); G8_SB; G8_GLDS((bc) + OFF_B + ldsw, b_ + voffB[0]); G8_SB; \
        G8_MF(AC, BC, 0, 3, 0); G8_MF(AC, BC, 0, 3, 1); G8_SB; G8_GLDS((bc) + OFF_B + ldsw + 8192, b_ + voffB[1]); G8_SB; \
        G8_MF(AC, BC, 1, 0, 0); G8_MF(AC, BC, 1, 0, 1); G8_SB; G8_GLDS((bc) + OFF_B + HTB + ldsw, b_ + hstepB + voffB[0]); G8_SB; \
        G8_MF(AC, BC, 1, 1, 0); G8_MF(AC, BC, 1, 1, 1); G8_SB; G8_GLDS((bc) + OFF_B + HTB + ldsw + 8192, b_ + hstepB + voffB[1]); G8_SB; \
        G8_MF(AC, BC, 1, 2, 0); G8_MF(AC, BC, 1, 2, 1); G8_MF(AC, BC, 1, 3, 0); G8_MF(AC, BC, 1, 3, 1); \
        __builtin_amdgcn_s_setprio(0); G8_SB; } while (0)
    G8_STAGE(0, cur.A, vc[0], vc[1], cur.B, 0); G8_STAGE(1, cur.A, vc[0], vc[1], cur.B, 1); G8_STAGE(2, cur.A, vc[0], vc[1], cur.B, 2);
    asm volatile("s_waitcnt vmcnt(12)" ::: "memory"); __builtin_amdgcn_s_barrier(); asm volatile("" ::: "memory");
    G8_READ(Ax, Bx, 0);
    int bc = 0;
#define G8_NEXTB(x) ((x) == 2 * BUF ? 0 : (x) + BUF)
#pragma unroll 1
    for (;;) {
        const bool has_next = S.next(ui + 1, nxt);
        if (Sched::GATHER) { if (has_next) { unsigned vn[2]; G8_AOFF(vn, nxt); LAS unsigned* vp_ = G8_VPARK(); vp_[0] = vn[0]; vp_[1] = vn[1]; } }
#pragma unroll 1
        for (int t = 0; t < nt; t += 2) {
            { const int kt = t + 3; const bool tl = kt >= nt;
              const char* sa = tl ? (has_next ? nxt.A : cur.A) : cur.A; const char* sb = tl ? (has_next ? nxt.B : cur.B) : cur.B; const int bl = G8_NEXTB(bc);
              G8_STEP(Ax, Bx, Ay, By, bc, bl, sa, vc[0], vc[1], sb, tl ? kt - nt : kt); bc = bl; }
            { const int kt = t + 4; const bool tl = kt >= nt;
              if (Sched::GATHER) { if (has_next && kt == nt) { const LAS unsigned* vp_ = G8_VPARK(); vc[0] = vp_[0]; vc[1] = vp_[1]; } }
              const char* sa = tl ? (has_next ? nxt.A : cur.A) : cur.A; const char* sb = tl ? (has_next ? nxt.B : cur.B) : cur.B; const int bl = G8_NEXTB(bc);
              G8_STEP(Ay, By, Ax, Bx, bc, bl, sa, vc[0], vc[1], sb, tl ? kt - nt : kt); bc = bl; }
        }
        { int tl_ = threadIdx.x; asm volatile("" : "+v"(tl_)); E(acc, cur, wr, wc, tl_ & 15, (tl_ & 63) >> 4); }
        if (!has_next) break;
#pragma unroll
        for (int b = 0; b < 2; ++b)
#pragma unroll
            for (int m = 0; m < 4; ++m)
#pragma unroll
                for (int n = 0; n < 2; ++n) acc[b][m][n] = (f32x4){0.f, 0.f, 0.f, 0.f};
        cur = nxt; ++ui;
    }
    asm volatile("s_waitcnt vmcnt(0) lgkmcnt(0)" ::: "memory"); __builtin_amdgcn_s_barrier(); asm volatile("" ::: "memory");
#undef G8_READ
#undef G8_AOFF
#undef G8_MF
#undef G8_SB
#undef G8_STEP
#undef G8_NEXTB
#undef G8_VPARK
#undef G8_GLDS
#undef G8_STAGE
#undef G8_LD8
}
struct EpiMoeGlu {
    unsigned char* act; const float* bgu;
    __device__ __forceinline__ void operator()(const f32x4 (&acc)[2][4][2], const Unit& u, int wr, int wc, int fr, int fq) const {
        const EpiGlu E{act, bgu, u.e, u.base}; const int r0 = u.pm * 128 + wr * 64 + fr, f0 = u.pn * 128 + wc * 32 + 8 * fq;
#pragma unroll
        for (int m = 0; m < 4; ++m) { const f32x4 g0 = acc[0][m][0], g1 = acc[0][m][1], u0 = acc[1][m][0], u1 = acc[1][m][1];
            const float g[8] = {g0[0], g0[1], g0[2], g0[3], g1[0], g1[1], g1[2], g1[3]}, uu[8] = {u0[0], u0[1], u0[2], u0[3], u1[0], u1[1], u1[2], u1[3]};
            E(r0 + m * 16, f0, g, uu); }
    }
};
struct EpiMoeDown {
    bf16_t* ys; const float* bd; const float* listg;
    __device__ __forceinline__ void operator()(const f32x4 (&acc)[2][4][2], const Unit& u, int wr, int wc, int fr, int fq) const {
        const EpiDown E{ys, bd, listg, u.e, u.base, u.cnt}; const int r0 = u.pm * 128 + wr * 64 + fr, c0 = u.pn * 256 + wc * 32 + 8 * fq;
#pragma unroll
        for (int m = 0; m < 4; ++m)
#pragma unroll
            for (int bj = 0; bj < 2; ++bj) { const f32x4 a = acc[bj][m][0], b = acc[bj][m][1]; const float v[8] = {a[0], a[1], a[2], a[3], b[0], b[1], b[2], b[3]}; E(r0 + m * 16, c0 + bj * 128, v); }
    }
};
template <bool GATH> struct MoeOrder {
    const char* A; const char* Bt; const u32* cnt; const int* list; int KB, nN, nfull, G, vcu, pad;
    static constexpr bool GATHER = GATH;
    __device__ __forceinline__ bool next(int i, Unit& u) const {
        const int L = i * G + vcu, mt = L / nN; int acc = 0, e = 0, c = 0;
        for (; e < NE; ++e) { c = (int)cnt[e * 64]; const int t = (c + 127) >> 7; if (mt < acc + t) break; acc += t; }
        if (e >= NE) return false;
        u.e = e; u.base = acc << 7; u.cnt = c; u.pm = mt - acc; u.pn = L - mt * nN; u.pad = 0;
        u.A = GATH ? A : A + (size_t)(u.base + u.pm * 128) * KB; u.B = Bt + ((size_t)e * nfull + (size_t)u.pn * 256) * KB; return true;
    }
    __device__ __forceinline__ unsigned arow(const Unit& u, int R) const {
        if (!GATH) return (unsigned)(R * KB);
        const int r = u.pm * 128 + R; const int tok = list[(size_t)u.e * NTOK + (r < u.cnt ? r : 0)]; return (unsigned)tok * (unsigned)KB;
    }
};
}

namespace att {
typedef float f32x16 __attribute__((ext_vector_type(16)));
typedef float f32x2_t __attribute__((ext_vector_type(2))); typedef __bf16 bf16x2_t __attribute__((ext_vector_type(2)));
__device__ __forceinline__ unsigned cvtpk(float lo, float hi) { f32x2_t v = {lo, hi}; bf16x2_t b = __builtin_convertvector(v, bf16x2_t); return __builtin_bit_cast(unsigned, b); }
__device__ __forceinline__ int crow(int r, int hi) { return (r & 3) + 8 * (r >> 2) + 4 * hi; }
constexpr int KTB = 12288, VTB = 8192, BUFB = KTB + VTB;
constexpr int NBUF = 4, LDS_NEED = NBUF * BUFB;
#define ATT_MFMA(a, b, c) __builtin_amdgcn_mfma_f32_32x32x16_bf16((a), (b), (c), 0, 0, 0)

__device__ __forceinline__ void attn_unit(LAS unsigned char* lds, int b, int h, int qb, const bf16_t* __restrict__ Q, const bf16_t* __restrict__ K, const bf16_t* __restrict__ VT, bf16_t* __restrict__ ycat) {
    const int tid = threadIdx.x, lane = tid & 63, r32 = lane & 31, hi = lane >> 5, w = __builtin_amdgcn_readfirstlane(tid >> 6);
    const int q0 = qb * 256 + w * 32;
    bf16x8 qf[6];
#pragma unroll
    for (int s = 0; s < 6; ++s) qf[s] = *(const bf16x8*)(Q + qk_off(b, h, q0 + r32, 2 * s + hi));
    const int NT = 4 * (qb + 1), tlast = 4 * qb + (w >> 1);
    const char* kbase = (const char*)K + (size_t)((b * NH + h) * 128) * KTB;
    const char* vbase = (const char*)VT + (size_t)((b * NH + h) * 128) * VTB;
#define ATT_ISSUE(t, bsel) do { _Pragma("unroll") for (int j_ = 0; j_ < 3; ++j_) { const int i_ = w + 8 * j_; if (i_ < 20) { \
        const char* src_ = (i_ < 12) ? kbase + (size_t)(t) * KTB + i_ * 1024 : vbase + (size_t)(t) * VTB + (i_ - 12) * 1024; \
        __builtin_amdgcn_global_load_lds((const unsigned*)(src_ + lane * 16), (LAS unsigned*)(lds + (bsel) * BUFB + i_ * 1024), 16, 0, 0); } } } while (0)
    f32x16 o0, o1, negm;
#pragma unroll
    for (int r = 0; r < 16; ++r) { o0[r] = 0.f; o1[r] = 0.f; negm[r] = 0.f; }
    float l_run = 0.f;
    const bool lag = (w >= 4);
    u32x4 pw[4];
#pragma unroll
    for (int i = 0; i < 4; ++i) pw[i] = (u32x4){0u, 0u, 0u, 0u};
#define ATT_PV() do { _Pragma("unroll") for (int s_ = 0; s_ < 4; ++s_) { const bf16x8 pf_ = __builtin_bit_cast(bf16x8, pw[s_]); o0 = ATT_MFMA(vf[2 * s_], pf_, o0); o1 = ATT_MFMA(vf[2 * s_ + 1], pf_, o1); } } while (0)
    ATT_ISSUE(0, 0); ATT_ISSUE(1, 1);
#pragma unroll 1
    for (int t = 0; t < NT; ++t) {
        if (t + 1 < NT) { if (w < 4) asm volatile("s_waitcnt vmcnt(3)" ::: "memory"); else asm volatile("s_waitcnt vmcnt(2)" ::: "memory"); }
        else asm volatile("s_waitcnt vmcnt(0)" ::: "memory");
        __builtin_amdgcn_s_barrier(); asm volatile("" ::: "memory");
        const int vt = lag ? t - 1 : t; const bool do_pv = (vt >= 0) && (vt <= tlast), do_qk = (t <= tlast);
        const LAS unsigned char* vp = lds + (vt & 3) * BUFB + KTB + (hi * 64 + r32) * 16; const LAS unsigned char* kp = lds + (t & 3) * BUFB + (hi * 64 + r32) * 16;
        bf16x8 vf[8], kf[12];
#pragma unroll
        for (int s = 0; s < 4; ++s) { vf[2 * s] = *(const LAS bf16x8*)(vp + s * 2048); vf[2 * s + 1] = *(const LAS bf16x8*)(vp + s * 2048 + 512); }
#pragma unroll
        for (int s = 0; s < 6; ++s) { kf[2 * s] = *(const LAS bf16x8*)(kp + s * 2048); kf[2 * s + 1] = *(const LAS bf16x8*)(kp + s * 2048 + 512); }
        asm volatile("s_waitcnt lgkmcnt(0)" ::: "memory");
        __builtin_amdgcn_sched_barrier(0);
        if (t + 2 < NT) ATT_ISSUE(t + 2, (t + 2) & 3);
        __builtin_amdgcn_sched_barrier(0);
        if (lag && do_pv) ATT_PV();
        if (do_qk) {
            f32x16 p0 = ATT_MFMA(kf[0], qf[0], negm), p1 = ATT_MFMA(kf[1], qf[0], negm);
#pragma unroll
            for (int s = 1; s < 6; ++s) { p0 = ATT_MFMA(kf[2 * s], qf[s], p0); p1 = ATT_MFMA(kf[2 * s + 1], qf[s], p1); }
            if (t == tlast) { const int qg = q0 + r32, kg = 64 * t + 4 * hi;
#pragma unroll
                for (int r = 0; r < 16; ++r) { const int key = kg + (r & 3) + 8 * (r >> 2); if (key > qg) p0[r] = -INFINITY; if (key + 32 > qg) p1[r] = -INFINITY; } }
            float mx = fmaxf(p0[0], p1[0]);
#pragma unroll
            for (int r = 1; r < 16; ++r) mx = fmaxf(mx, fmaxf(p0[r], p1[r]));
            mx = fmaxf(mx, __shfl_xor(mx, 32));
            if (t == 0 || __any(mx > 0.f)) {
                const float dl = (t == 0) ? mx : fmaxf(mx, 0.f), alpha = __builtin_amdgcn_exp2f(-dl); l_run *= alpha;
#pragma unroll
                for (int r = 0; r < 16; ++r) { o0[r] *= alpha; o1[r] *= alpha; negm[r] -= dl; p0[r] -= dl; p1[r] -= dl; }
            }
            float rs = 0.f;
#pragma unroll
            for (int r = 0; r < 16; ++r) { p0[r] = __builtin_amdgcn_exp2f(p0[r]); p1[r] = __builtin_amdgcn_exp2f(p1[r]); rs += p0[r] + p1[r]; }
            l_run += rs;
#pragma unroll
            for (int i = 0; i < 4; ++i) { pw[0][i] = cvtpk(p0[2 * i], p0[2 * i + 1]); pw[1][i] = cvtpk(p0[8 + 2 * i], p0[9 + 2 * i]); pw[2][i] = cvtpk(p1[2 * i], p1[2 * i + 1]); pw[3][i] = cvtpk(p1[8 + 2 * i], p1[9 + 2 * i]); }
        }
        if (!lag && do_pv) ATT_PV();
    }
    if (lag && tlast == NT - 1) {
        const LAS unsigned char* vp = lds + ((NT - 1) & 3) * BUFB + KTB + (hi * 64 + r32) * 16; bf16x8 vf[8];
#pragma unroll
        for (int s = 0; s < 4; ++s) { vf[2 * s] = *(const LAS bf16x8*)(vp + s * 2048); vf[2 * s + 1] = *(const LAS bf16x8*)(vp + s * 2048 + 512); }
        ATT_PV();
    }
#undef ATT_PV
    const float l_tot = l_run + __shfl_xor(l_run, 32), inv = 1.f / l_tot;
    bf16_t* orow = ycat + (size_t)(b * SEQ + q0 + r32) * DM + 512 + h * 64 + 4 * hi;
#pragma unroll
    for (int g = 0; g < 4; ++g) {
        u32x2 a, c; a.x = cvtpk(o0[4 * g] * inv, o0[4 * g + 1] * inv); a.y = cvtpk(o0[4 * g + 2] * inv, o0[4 * g + 3] * inv);
        c.x = cvtpk(o1[4 * g] * inv, o1[4 * g + 1] * inv); c.y = cvtpk(o1[4 * g + 2] * inv, o1[4 * g + 3] * inv);
        *(u32x2*)(orow + 8 * g) = a; *(u32x2*)(orow + 32 + 8 * g) = c;
    }
    asm volatile("s_waitcnt lgkmcnt(0)" ::: "memory"); __builtin_amdgcn_s_barrier(); asm volatile("" ::: "memory");
#undef ATT_ISSUE
}
__device__ __forceinline__ void attn_phase(LAS unsigned char* lds, int vcu, int G, const bf16_t* Q, const bf16_t* K, const bf16_t* VT, bf16_t* ycat) {
    for (int idx = vcu; idx < NB * NH * 16; idx += G) { const int bh = idx >> 4, s = idx & 15;
        attn_unit(lds, bh >> 3, bh & 7, 31 - s, Q, K, VT, ycat);
        attn_unit(lds, bh >> 3, bh & 7, s, Q, K, VT, ycat); }
}
}

namespace ssd {
using att::f32x16; using att::cvtpk;
constexpr int PITCH = 272;
constexpr int L_CM = 0, L_BM = 34816, L_BWT = 69632, L_XT = 104448, L_SDT = 121856, L_SACUM = L_SDT + 512, L_END = L_SACUM + 512;
constexpr int F_CM = 0, F_SAC = 34816, F_TMP = F_SAC + 2048, F_PART = F_TMP + 2048, F_END = F_PART + 4096;
#define SSD_MFMA(a, b, c) __builtin_amdgcn_mfma_f32_32x32x16_bf16((a), (b), (c), 0, 0, 0)
__device__ __forceinline__ int qpos(int s) { return (s & ~12) | ((s & 4) << 1) | ((s & 8) >> 1); }
__device__ __forceinline__ float softplus(float v) { return v > 20.f ? v : log1pf(__expf(v)); }
__device__ __forceinline__ int crow(int r, int hi) { return (r & 3) + 8 * (r >> 2) + 4 * hi; }

__device__ __forceinline__ void conv_item(const bf16_t* __restrict__ proj, const float* __restrict__ cw, const float* __restrict__ cb, int b, int c, int ch0, int l0, float (&out)[4][8]) {
    float w[4][8], bias[8];
#pragma unroll
    for (int k = 0; k < 4; ++k) { const f32x4 w0 = *(const f32x4*)(cw + k * 1024 + ch0), w1 = *(const f32x4*)(cw + k * 1024 + ch0 + 4); w[k][0] = w0[0]; w[k][1] = w0[1]; w[k][2] = w0[2]; w[k][3] = w0[3]; w[k][4] = w1[0]; w[k][5] = w1[1]; w[k][6] = w1[2]; w[k][7] = w1[3]; }
    { const f32x4 b0 = *(const f32x4*)(cb + ch0), b1 = *(const f32x4*)(cb + ch0 + 4); bias[0] = b0[0]; bias[1] = b0[1]; bias[2] = b0[2]; bias[3] = b0[3]; bias[4] = b1[0]; bias[5] = b1[1]; bias[6] = b1[2]; bias[7] = b1[3]; }
#pragma unroll
    for (int i = 0; i < 4; ++i)
#pragma unroll
        for (int j = 0; j < 8; ++j) out[i][j] = bias[j];
    const int t0 = c * CHUNK + l0;
#pragma unroll
    for (int rr = 0; rr < 7; ++rr) {
        const int t = t0 - 3 + rr; float in[8];
        if (t >= 0) load8(proj + (size_t)(b * SEQ + t) * 1536 + 512 + ch0, in);
        else {
#pragma unroll
            for (int j = 0; j < 8; ++j) in[j] = 0.f; }
#pragma unroll
        for (int k = 0; k < 4; ++k) { const int i = rr - k; if (i >= 0 && i < 4) {
#pragma unroll
            for (int j = 0; j < 8; ++j) out[i][j] += w[k][j] * in[j]; } }
    }
#pragma unroll
    for (int i = 0; i < 4; ++i)
#pragma unroll
        for (int j = 0; j < 8; ++j) out[i][j] = silu(out[i][j]);
}
__device__ __forceinline__ void scan128(const LAS float* src, LAS float* dst, int lane) {
    const float v0 = src[2 * lane], v1 = src[2 * lane + 1]; const float s = v0 + v1; float incl = s;
#pragma unroll
    for (int o = 1; o < 64; o <<= 1) { const float t = __shfl_up(incl, o); if (lane >= o) incl += t; }
    const float excl = incl - s; dst[2 * lane] = excl + v0; dst[2 * lane + 1] = excl + s;
}
#define SSD_BAR() do { asm volatile("s_waitcnt lgkmcnt(0)" ::: "memory"); __builtin_amdgcn_s_barrier(); asm volatile("" ::: "memory"); } while (0)

__device__ __forceinline__ void chunk_unit(LAS unsigned char* lds, int b, int c, int h, const bf16_t* __restrict__ proj, const float* __restrict__ dtr, const float* __restrict__ cw, const float* __restrict__ cb,
                                           const float* __restrict__ dt_bias, const float* __restrict__ a_log, const float* __restrict__ d_skip, float* __restrict__ Y, float* __restrict__ states, float* __restrict__ cd) {
    const int tid = threadIdx.x, lane = tid & 63, r32 = lane & 31, hi = lane >> 5, w = __builtin_amdgcn_readfirstlane(tid >> 6);
    const int g = h >> 2, tok0 = b * SEQ + c * CHUNK;
    LAS float* sdt = (LAS float*)(lds + L_SDT); LAS float* sacum = (LAS float*)(lds + L_SACUM);
    const float a = -__expf(a_log[h]);
    if (tid < 128) { const float dt = softplus(dtr[(size_t)(tok0 + tid) * 8 + h] + dt_bias[h]); sdt[tid] = dt; sacum[tid] = dt * a; }
    SSD_BAR();
    if (w == 0) scan128(sacum, sacum, lane);
    SSD_BAR();
    const float aend = sacum[127];
    if (tid == 0) cd[(b * 64 + c) * 8 + h] = __expf(aend);
    for (int item = tid; item < 40 * 32; item += NTHR) {
        const int cg = item >> 5, l0 = (item & 31) * 4; float o[4][8];
        if (cg < 8) {
            conv_item(proj, cw, cb, b, c, h * 64 + cg * 8, l0, o);
#pragma unroll
            for (int i = 0; i < 4; ++i) { const int q = qpos(l0 + i);
#pragma unroll
                for (int j = 0; j < 8; ++j) *(LAS bf16_t*)(lds + L_XT + (cg * 8 + j) * PITCH + q * 2) = (bf16_t)f2bf(o[i][j]); }
        } else if (cg < 24) {
            const int n0 = (cg - 8) * 8; conv_item(proj, cw, cb, b, c, 512 + g * 128 + n0, l0, o);
#pragma unroll
            for (int i = 0; i < 4; ++i) { const int s = l0 + i, q = qpos(s); const float wl = sdt[s] * __expf(aend - sacum[s]);
                u32x4 pk; pk.x = pk2(o[i][0], o[i][1]); pk.y = pk2(o[i][2], o[i][3]); pk.z = pk2(o[i][4], o[i][5]); pk.w = pk2(o[i][6], o[i][7]);
                *(LAS u32x4*)(lds + L_BM + s * PITCH + n0 * 2) = pk;
#pragma unroll
                for (int j = 0; j < 8; ++j) *(LAS bf16_t*)(lds + L_BWT + (n0 + j) * PITCH + q * 2) = (bf16_t)f2bf(o[i][j] * wl); }
        } else {
            const int n0 = (cg - 24) * 8; conv_item(proj, cw, cb, b, c, 768 + g * 128 + n0, l0, o);
#pragma unroll
            for (int i = 0; i < 4; ++i) { u32x4 pk; pk.x = pk2(o[i][0], o[i][1]); pk.y = pk2(o[i][2], o[i][3]); pk.z = pk2(o[i][4], o[i][5]); pk.w = pk2(o[i][6], o[i][7]);
                *(LAS u32x4*)(lds + L_CM + (l0 + i) * PITCH + n0 * 2) = pk; }
        }
    }
    SSD_BAR();
    const int lb = w & 3, pb = w >> 2;
    f32x16 yacc;
#pragma unroll
    for (int r = 0; r < 16; ++r) yacc[r] = 0.f;
    const float acl = sacum[lb * 32 + r32];
#pragma unroll 1
    for (int sb = 0; sb <= lb; ++sb) {
        f32x16 X;
#pragma unroll
        for (int r = 0; r < 16; ++r) X[r] = 0.f;
#pragma unroll
        for (int ks = 0; ks < 8; ++ks) {
            const bf16x8 af = *(const LAS bf16x8*)(lds + L_BM + (sb * 32 + r32) * PITCH + (16 * ks + 8 * hi) * 2);
            const bf16x8 bfr = *(const LAS bf16x8*)(lds + L_CM + (lb * 32 + r32) * PITCH + (16 * ks + 8 * hi) * 2);
            X = SSD_MFMA(af, bfr, X);
        }
        float mv[16];
#pragma unroll
        for (int gq = 0; gq < 4; ++gq) { const int sb0 = sb * 32 + 8 * gq + 4 * hi; const f32x4 ac = *(const LAS f32x4*)(sacum + sb0), dv = *(const LAS f32x4*)(sdt + sb0);
#pragma unroll
            for (int i = 0; i < 4; ++i) { const float val = X[4 * gq + i] * __expf(acl - ac[i]) * dv[i]; const bool masked = (sb == lb) && (8 * gq + 4 * hi + i > r32); mv[4 * gq + i] = masked ? 0.f : val; } }
        u32x4 pw0, pw1;
#pragma unroll
        for (int i = 0; i < 4; ++i) { pw0[i] = cvtpk(mv[2 * i], mv[2 * i + 1]); pw1[i] = cvtpk(mv[8 + 2 * i], mv[9 + 2 * i]); }
        const bf16x8 x0 = *(const LAS bf16x8*)(lds + L_XT + (pb * 32 + r32) * PITCH + (32 * sb + 8 * hi) * 2), x1 = *(const LAS bf16x8*)(lds + L_XT + (pb * 32 + r32) * PITCH + (32 * sb + 16 + 8 * hi) * 2);
        yacc = SSD_MFMA(x0, __builtin_bit_cast(bf16x8, pw0), yacc);
        yacc = SSD_MFMA(x1, __builtin_bit_cast(bf16x8, pw1), yacc);
    }
    f32x16 st;
#pragma unroll
    for (int r = 0; r < 16; ++r) st[r] = 0.f;
#pragma unroll
    for (int ks = 0; ks < 8; ++ks) {
        const bf16x8 af = *(const LAS bf16x8*)(lds + L_BWT + (lb * 32 + r32) * PITCH + (16 * ks + 8 * hi) * 2);
        const bf16x8 bfr = *(const LAS bf16x8*)(lds + L_XT + (pb * 32 + r32) * PITCH + (16 * ks + 8 * hi) * 2);
        st = SSD_MFMA(af, bfr, st);
    }
    { const float dsk = d_skip[h]; const int l = lb * 32 + r32, ql = qpos(l); float* yrow = Y + (size_t)(tok0 + l) * 512 + h * 64 + pb * 32 + 4 * hi;
#pragma unroll
      for (int gq = 0; gq < 4; ++gq) { f32x4 o;
#pragma unroll
        for (int i = 0; i < 4; ++i) { const int p = pb * 32 + 8 * gq + 4 * hi + i; o[i] = yacc[4 * gq + i] + dsk * bf2f(*(const LAS bf16_t*)(lds + L_XT + p * PITCH + ql * 2)); }
        *(f32x4*)(yrow + 8 * gq) = o; }
      float* srow = states + ((size_t)((b * 64 + c) * 8 + h) * 64 + pb * 32 + r32) * 128 + lb * 32 + 4 * hi;
#pragma unroll
      for (int gq = 0; gq < 4; ++gq) *(f32x4*)(srow + 8 * gq) = (f32x4){st[4 * gq], st[4 * gq + 1], st[4 * gq + 2], st[4 * gq + 3]}; }
    SSD_BAR();
}

__device__ __forceinline__ void scan_phase(int vcu, int G, const float* __restrict__ states, float* __restrict__ prev, const float* __restrict__ cd) {
    for (int gid = vcu * NTHR + threadIdx.x; gid < NB * 65536; gid += G * NTHR) {
        const int b = gid >> 16, rem = gid & 65535, h = rem >> 13; const float* p = states + (size_t)b * 64 * 65536 + rem; float* q = prev + (size_t)b * 64 * 65536 + rem; const float* cdp = cd + b * 64 * 8 + h;
        float hs = 0.f;
#pragma unroll 1
        for (int c0 = 0; c0 < 64; c0 += 8) { float s[8], d[8];
#pragma unroll
            for (int i = 0; i < 8; ++i) { s[i] = p[(size_t)(c0 + i) * 65536]; d[i] = cdp[(c0 + i) * 8]; }
#pragma unroll
            for (int i = 0; i < 8; ++i) { q[(size_t)(c0 + i) * 65536] = hs; hs = hs * d[i] + s[i]; } }
    }
}

__device__ __forceinline__ void final_unit(LAS unsigned char* lds, int b, int c, int g, const bf16_t* __restrict__ proj, const float* __restrict__ dtr, const float* __restrict__ cw, const float* __restrict__ cb,
                                           const float* __restrict__ dt_bias, const float* __restrict__ a_log, const float* __restrict__ ng, const float* __restrict__ Y, const float* __restrict__ states, bf16_t* __restrict__ ycat) {
    const int tid = threadIdx.x, lane = tid & 63, r32 = lane & 31, hi = lane >> 5, w = __builtin_amdgcn_readfirstlane(tid >> 6);
    const int tok0 = b * SEQ + c * CHUNK;
    LAS float* sac = (LAS float*)(lds + F_SAC); LAS float* tmp = (LAS float*)(lds + F_TMP); LAS float* part = (LAS float*)(lds + F_PART);
    { const int j = tid >> 7, l = tid & 127, hh = 4 * g + j; const float dt = softplus(dtr[(size_t)(tok0 + l) * 8 + hh] + dt_bias[hh]); tmp[j * 128 + l] = dt * (-__expf(a_log[hh])); }
    SSD_BAR();
    if (w < 4) scan128(tmp + w * 128, sac + w * 128, lane);
    { const int cgi = tid >> 5, l0 = (tid & 31) * 4, n0 = cgi * 8; float o[4][8];
      conv_item(proj, cw, cb, b, c, 768 + g * 128 + n0, l0, o);
#pragma unroll
      for (int i = 0; i < 4; ++i) { u32x4 pk; pk.x = pk2(o[i][0], o[i][1]); pk.y = pk2(o[i][2], o[i][3]); pk.z = pk2(o[i][4], o[i][5]); pk.w = pk2(o[i][6], o[i][7]);
          *(LAS u32x4*)(lds + F_CM + (l0 + i) * PITCH + n0 * 2) = pk; } }
    SSD_BAR();
    const int j = w >> 1, pb = w & 1, head = 4 * g + j;
    bf16x8 af[8];
    { const float* sp = states + ((size_t)((b * 64 + c) * 8 + head) * 64 + pb * 32 + r32) * 128 + 8 * hi;
#pragma unroll
      for (int ks = 0; ks < 8; ++ks) { const f32x4 s0 = *(const f32x4*)(sp + 16 * ks), s1 = *(const f32x4*)(sp + 16 * ks + 4); u32x4 pk; pk.x = cvtpk(s0[0], s0[1]); pk.y = cvtpk(s0[2], s0[3]); pk.z = cvtpk(s1[0], s1[1]); pk.w = cvtpk(s1[2], s1[3]); af[ks] = __builtin_bit_cast(bf16x8, pk); } }
    float yv[4][16];
#pragma unroll
    for (int lb = 0; lb < 4; ++lb) {
        f32x16 acc;
#pragma unroll
        for (int r = 0; r < 16; ++r) acc[r] = 0.f;
#pragma unroll
        for (int ks = 0; ks < 8; ++ks) { const bf16x8 bfr = *(const LAS bf16x8*)(lds + F_CM + (lb * 32 + r32) * PITCH + (16 * ks + 8 * hi) * 2); acc = SSD_MFMA(af[ks], bfr, acc); }
        const int l = lb * 32 + r32; const float e = __expf(sac[j * 128 + l]); float ss = 0.f;
        const float* yrow = Y + (size_t)(tok0 + l) * 512 + head * 64 + pb * 32 + 4 * hi; const bf16_t* zrow = proj + (size_t)(tok0 + l) * 1536 + head * 64 + pb * 32 + 4 * hi;
#pragma unroll
        for (int gq = 0; gq < 4; ++gq) { const f32x4 yd = *(const f32x4*)(yrow + 8 * gq); const u32x2 zz = *(const u32x2*)(zrow + 8 * gq);
            const float z[4] = {__uint_as_float(zz.x << 16), __uint_as_float(zz.x & 0xffff0000u), __uint_as_float(zz.y << 16), __uint_as_float(zz.y & 0xffff0000u)};
#pragma unroll
            for (int i = 0; i < 4; ++i) { const float v = (acc[4 * gq + i] * e + yd[i]) * silu(z[i]); yv[lb][4 * gq + i] = v; ss += v * v; } }
        ss += __shfl_xor(ss, 32);
        if (hi == 0) part[l * 8 + w] = ss;
    }
    SSD_BAR();
#pragma unroll
    for (int lb = 0; lb < 4; ++lb) { const int l = lb * 32 + r32; const f32x4 p0 = *(const LAS f32x4*)(part + l * 8), p1 = *(const LAS f32x4*)(part + l * 8 + 4);
        const float rstd = rsqrtf(((p0[0] + p0[1]) + (p0[2] + p0[3]) + (p1[0] + p1[1]) + (p1[2] + p1[3])) * (1.f / 256.f) + EPS);
        bf16_t* orow = ycat + (size_t)(tok0 + l) * DM + head * 64 + pb * 32 + 4 * hi; const float* gp = ng + head * 64 + pb * 32 + 4 * hi;
#pragma unroll
        for (int gq = 0; gq < 4; ++gq) { const f32x4 gg = *(const f32x4*)(gp + 8 * gq); u32x2 o; o.x = cvtpk(yv[lb][4 * gq] * rstd * gg[0], yv[lb][4 * gq + 1] * rstd * gg[1]); o.y = cvtpk(yv[lb][4 * gq + 2] * rstd * gg[2], yv[lb][4 * gq + 3] * rstd * gg[3]);
            *(u32x2*)(orow + 8 * gq) = o; } }
    SSD_BAR();
}
}

constexpr int CNT_STRIDE = 64;
__device__ __forceinline__ void router_phase(LAS unsigned char* lds, int vcu, int G, const float* __restrict__ x1, const float* __restrict__ g, const float* __restrict__ wr, const float* __restrict__ br, unsigned char* __restrict__ h2,
                                             u32* __restrict__ cnt, int* __restrict__ list, float* __restrict__ listg, int* __restrict__ toke, int* __restrict__ tokp) {
    const int tid = threadIdx.x, lane = tid & 63, w = __builtin_amdgcn_readfirstlane(tid >> 6), e = lane & 31, half = lane >> 5;
    LAS float* hvs = (LAS float*)(lds + w * 16384);
    LAS int* ssel = (LAS int*)(lds + LDSCTL_OFF + 1024); LAS float* sgw = (LAS float*)(lds + LDSCTL_OFF + 2048);
    LAS unsigned* hist = (LAS unsigned*)(lds + LDSCTL_OFF + 3072); LAS unsigned* sbase = hist + 32;
    const f32x4 br4 = *(const f32x4*)(br + 4 * (lane & 7));
#pragma unroll 1
    for (int grp = vcu; grp < NTOK / 64; grp += G) {
        if (tid < 32) hist[tid] = 0u;
#pragma unroll 1
        for (int bt = 0; bt < 2; ++bt) {
            const int tl0 = w * 8 + bt * 4, tok0 = grp * 64 + tl0;
#pragma unroll
            for (int t = 0; t < 4; ++t) {
                const f32x4* xr = (const f32x4*)(x1 + (size_t)(tok0 + t) * DM) + lane; f32x4 v[4]; float ss = 0.f;
#pragma unroll
                for (int j = 0; j < 4; ++j) { v[j] = xr[64 * j]; ss += v[j].x * v[j].x + v[j].y * v[j].y + v[j].z * v[j].z + v[j].w * v[j].w; }
                const float r = rsqrtf(wave_sum(ss) * (1.f / DM) + EPS);
#pragma unroll
                for (int j = 0; j < 4; ++j) { const f32x4 gg = ((const f32x4*)g)[lane + 64 * j]; const f32x4 hv = {v[j].x * r * gg.x, v[j].y * r * gg.y, v[j].z * r * gg.z, v[j].w * r * gg.w};
                    *(u32*)(h2 + (size_t)(tok0 + t) * DM + 4 * (lane + 64 * j)) = pk4_fp8(hv[0], hv[1], hv[2], hv[3]);
                    *(LAS f32x4*)(hvs + t * 1024 + 4 * (lane + 64 * j)) = hv; }
            }
            asm volatile("s_waitcnt lgkmcnt(0)" ::: "memory");
            float acc[4][4];
#pragma unroll
            for (int t = 0; t < 4; ++t)
#pragma unroll
                for (int q = 0; q < 4; ++q) acc[t][q] = 0.f;
            const int e4 = lane & 7, dsb = lane >> 3;
            const float* wp = wr + (size_t)(dsb * 128) * NE + 4 * e4; const LAS float* hp = hvs + dsb * 128;
#pragma unroll 2
            for (int d = 0; d < 128; d += 4) {
                f32x4 wv[4];
#pragma unroll
                for (int i = 0; i < 4; ++i) wv[i] = *(const f32x4*)(wp + (size_t)(d + i) * NE);
#pragma unroll
                for (int t = 0; t < 4; ++t) { const f32x4 h0 = *(const LAS f32x4*)(hp + t * 1024 + d);
#pragma unroll
                    for (int q = 0; q < 4; ++q) acc[t][q] += (h0[0] * wv[0][q] + h0[1] * wv[1][q]) + (h0[2] * wv[2][q] + h0[3] * wv[3][q]); }
            }
#pragma unroll
            for (int t = 0; t < 4; ++t)
#pragma unroll
                for (int q = 0; q < 4; ++q) { float v = acc[t][q]; v += __shfl_xor(v, 8); v += __shfl_xor(v, 16); v += __shfl_xor(v, 32); acc[t][q] = v + br4[q]; }
#pragma unroll
            for (int t = 0; t < 4; ++t) {
                int sel[4]; float sv[4];
#pragma unroll
                for (int k = 0; k < 4; ++k) { float bv = acc[t][0]; int bi = 4 * e4;
#pragma unroll
                    for (int q = 1; q < 4; ++q) if (acc[t][q] > bv) { bv = acc[t][q]; bi = 4 * e4 + q; }
#pragma unroll
                    for (int o = 1; o < 8; o <<= 1) { const float ov = __shfl_xor(bv, o); const int oi = __shfl_xor(bi, o); if (ov > bv || (ov == bv && oi < bi)) { bv = ov; bi = oi; } }
                    sel[k] = bi; sv[k] = bv;
#pragma unroll
                    for (int q = 0; q < 4; ++q) if (bi == 4 * e4 + q) acc[t][q] = -3.0e38f; }
                const float e1 = __expf(sv[1] - sv[0]), e2 = __expf(sv[2] - sv[0]), e3 = __expf(sv[3] - sv[0]), inv = 1.f / (1.f + e1 + e2 + e3);
                if (lane == 0) { *(LAS u32x4*)(ssel + (tl0 + t) * 4) = (u32x4){(u32)sel[0], (u32)sel[1], (u32)sel[2], (u32)sel[3]}; *(LAS f32x4*)(sgw + (tl0 + t) * 4) = (f32x4){inv, e1 * inv, e2 * inv, e3 * inv}; }
            }
        }
        SSD_BAR();
        int myE = 0; unsigned rank = 0u;
        if (tid < 256) { myE = ssel[tid]; rank = __hip_atomic_fetch_add(hist + myE, 1u, __ATOMIC_RELAXED, __HIP_MEMORY_SCOPE_WORKGROUP); }
        SSD_BAR();
        if (tid < 32) { const unsigned c = hist[tid]; sbase[tid] = c ? atomicAdd(cnt + tid * CNT_STRIDE, c) : 0u; }
        SSD_BAR();
        if (tid < 256) { const unsigned p = sbase[myE] + rank; const int tok = grp * 64 + (tid >> 2);
            list[(size_t)myE * NTOK + p] = tok; listg[(size_t)myE * NTOK + p] = sgw[tid]; toke[tok * 4 + (tid & 3)] = myE; tokp[tok * 4 + (tid & 3)] = (int)p; }
        SSD_BAR();
    }
}
__device__ __forceinline__ void combine_phase(int gw, int NGW, int lane, const float* __restrict__ x1, const bf16_t* __restrict__ ys, const u32* __restrict__ cnt, const int* __restrict__ toke, const int* __restrict__ tokp, const float* __restrict__ g, float* __restrict__ out) {
    int tiles = lane < 32 ? (int)((cnt[(lane & 31) * CNT_STRIDE] + 127) >> 7) : 0, incl = tiles;
#pragma unroll
    for (int o = 1; o < 32; o <<= 1) { const int t = __shfl_up(incl, o); if ((lane & 31) >= o) incl += t; }
    const int excl = (incl - tiles) << 7;
#pragma unroll 1
    for (int tok = gw; tok < NTOK; tok += NGW) {
        f32x4 v[4];
#pragma unroll
        for (int j = 0; j < 4; ++j) v[j] = ((const f32x4*)(x1 + (size_t)tok * DM))[lane + 64 * j];
#pragma unroll
        for (int k = 0; k < 4; ++k) { const int e = toke[tok * 4 + k], p = tokp[tok * 4 + k]; const int srow = __shfl(excl, e) + p; const bf16_t* yr = ys + (size_t)srow * DM;
#pragma unroll
            for (int j = 0; j < 4; ++j) { const u32x2 w = *(const u32x2*)(yr + 4 * (lane + 64 * j));
                v[j].x += __uint_as_float(w.x << 16); v[j].y += __uint_as_float(w.x & 0xffff0000u); v[j].z += __uint_as_float(w.y << 16); v[j].w += __uint_as_float(w.y & 0xffff0000u); } }
        float ss = 0.f;
#pragma unroll
        for (int j = 0; j < 4; ++j) ss += v[j].x * v[j].x + v[j].y * v[j].y + v[j].z * v[j].z + v[j].w * v[j].w;
        const float r = rsqrtf(wave_sum(ss) * (1.f / DM) + EPS);
#pragma unroll
        for (int j = 0; j < 4; ++j) { const f32x4 gg = ((const f32x4*)g)[lane + 64 * j]; ((f32x4*)(out + (size_t)tok * DM))[lane + 64 * j] = (f32x4){v[j].x * r * gg.x, v[j].y * r * gg.y, v[j].z * r * gg.z, v[j].w * r * gg.w}; }
    }
}

struct Frame { LAS unsigned char* lds; int tid, lane, wave, G, vcu; };

typedef const unsigned char __attribute__((address_space(4)))* kaptr_t;
#define KARG(kap_, idx) (*(const void* const __attribute__((address_space(4)))*)((kap_) + 8 * (idx)))
__device__ __forceinline__ void p0_prologue(const Frame& F, kaptr_t kap) {
    unsigned char* ws = (unsigned char*)KARG(kap, 24);
    const int gw = F.vcu * NWAVES + F.wave, NGW = F.G * NWAVES;
    constexpr int T_IN = 16 * 32, T_UQ = 4 * 12, T_KN = 2 * 8, T_V = 2 * 8, T_OUT = 16 * 16, T_GU = 16 * 32, T_DN = 16 * 16;
    constexpr int NT = T_IN + T_UQ + T_KN + T_V + T_OUT + NE * T_GU + NE * T_DN;
    for (int it = gw; it < NT; it += NGW) {
        int r = it;
        if (r < T_IN) { p0_tile((const float*)KARG(kap, 3), IN_W, 1024, nullptr, (bf16_t*)(ws + WS_WIN), (r >> 5) * 64, (r & 31) * 64, MapIn{}, F.lane); continue; } r -= T_IN;
        if (r < T_UQ) { p0_tile((const float*)KARG(kap, 11), 768, 256, (const float*)KARG(kap, 10), (bf16_t*)(ws + WS_WUQ), (r / 12) * 64, (r % 12) * 64, MapQ{}, F.lane); continue; } r -= T_UQ;
        if (r < T_KN) { p0_tile((const float*)KARG(kap, 13), 1024, 128, (const float*)KARG(kap, 12), (bf16_t*)(ws + WS_WKN), (r >> 3) * 64, (r & 7) * 64, MapKn{}, F.lane); continue; } r -= T_KN;
        if (r < T_V) { p0_tile((const float*)KARG(kap, 13), 1024, 128, (const float*)KARG(kap, 12), (bf16_t*)(ws + WS_WV), (r >> 3) * 64, (r & 7) * 64, MapV{}, F.lane); continue; } r -= T_V;
        if (r < T_OUT) { p0_tile((const float*)KARG(kap, 14), 1024, 1024, nullptr, (bf16_t*)(ws + WS_WOUT), (r >> 4) * 64, (r & 15) * 64, MapId{}, F.lane); continue; } r -= T_OUT;
        if (r < NE * T_GU) { const int e = r / T_GU, q = r % T_GU; p0_tile8((const float*)KARG(kap, 18) + (size_t)e * 1024 * 2048, 2048, 1024, (unsigned char*)(ws + WS_WGU) + (size_t)e * 2048 * 1024, (q >> 5) * 64, (q & 31) * 64, MapGU{}, F.lane); continue; } r -= NE * T_GU;
        { const int e = r / T_DN, q = r % T_DN; p0_tile8((const float*)KARG(kap, 20) + (size_t)e * 1024 * 1024, 1024, 1024, (unsigned char*)(ws + WS_WDN) + (size_t)e * 1024 * 1024, (q >> 4) * 64, (q & 15) * 64, MapId{}, F.lane); }
    }
    { const float* x = (const float*)KARG(kap, 0); const float* g = (const float*)KARG(kap, 2); bf16_t* H = (bf16_t*)(ws + WS_H);
      for (int row = gw; row < NTOK; row += NGW) {
        const f32x4* xr = (const f32x4*)(x + (size_t)row * DM) + F.lane; f32x4 v[4]; float ss = 0.f;
#pragma unroll
        for (int j = 0; j < 4; ++j) { v[j] = xr[64 * j]; ss += v[j].x * v[j].x + v[j].y * v[j].y + v[j].z * v[j].z + v[j].w * v[j].w; }
        const float r = rsqrtf(wave_sum(ss) * (1.f / DM) + EPS);
#pragma unroll
        for (int j = 0; j < 4; ++j) { const f32x4 gg = ((const f32x4*)g)[F.lane + 64 * j]; u32x2 w; w.x = pk2(v[j].x * r * gg.x, v[j].y * r * gg.y); w.y = pk2(v[j].z * r * gg.z, v[j].w * r * gg.w);
            *(u32x2*)(H + (size_t)row * DM + 4 * (F.lane + 64 * j)) = w; }
      } }
    { const int* pos = (const int*)KARG(kap, 1); float* rc = (float*)(ws + WS_ROPEC); float* rs = (float*)(ws + WS_ROPES);
      for (int idx = F.vcu * NTHR + F.tid; idx < NTOK * 16; idx += F.G * NTHR) { const int tok = idx >> 4, i = idx & 15;
        double t = (double)pos[tok] * INVF2PI[i]; t -= floor(t); const float fr = (float)t; rc[idx] = __builtin_amdgcn_cosf(fr); rs[idx] = __builtin_amdgcn_sinf(fr); } }
}

#ifndef PROBE_REP
#define PROBE_REP -1
#endif
#define REPS(k) for (int rep_ = 0; rep_ < ((PROBE_REP) == (k) ? 2 : 1); ++rep_)
__global__ void __launch_bounds__(NTHR, 2) mega(Args args) {
    extern __shared__ __attribute__((aligned(16))) unsigned char lds_raw[];
    Frame F; F.lds = (LAS unsigned char*)lds_raw;
    F.tid = threadIdx.x; F.lane = F.tid & 63; F.wave = __builtin_amdgcn_readfirstlane(F.tid >> 6);
    F.G = gridDim.x; { const int bx = blockIdx.x; F.vcu = (F.G % 8 == 0) ? (bx % 8) * (F.G / 8) + bx / 8 : bx; }
    volatile LAS unsigned* MISC = (volatile LAS unsigned*)(F.lds + MISC_OFF);
    for (int u = F.tid; u < (LDS_BYTES - LDSCTL_OFF) / 4; u += NTHR) ((LAS unsigned*)(F.lds + LDSCTL_OFF))[u] = 0u;
    __syncthreads();
    kaptr_t kap = (kaptr_t)__builtin_amdgcn_kernarg_segment_ptr();
#define RELOAD_ARGS() do { asm volatile("" : "+s"(kap)); F.tid = threadIdx.x; asm volatile("" : "+v"(F.tid)); F.lane = F.tid & 63; F.wave = __builtin_amdgcn_readfirstlane(F.tid >> 6); } while (0)
    unsigned char* ws = (unsigned char*)KARG(kap, 24);
    unsigned* ctl = (unsigned*)(ws + WS_CTL);
    const int lo = *(const int __attribute__((address_space(4)))*)(kap + 200), hi = *(const int __attribute__((address_space(4)))*)(kap + 204);
    XcdBarrier bar; bar.bar = ctl + CW_BAR; bar.x = 0; bar.st = nullptr;
    if (hi - lo > 1) bar = xcd_barrier_post(ctl + CW_BAR, MISC + 8);
#define IN(k) (lo <= (k) && (k) < hi)
#define SEAM(k) do { if (IN(k) && IN((k) + 1)) { xcd_barrier(bar); if (PROBE_REP == 100) xcd_barrier(bar); } } while (0)

    if (IN(0)) REPS(0) { RELOAD_ARGS(); p0_prologue(F, kap); } SEAM(0);
    if (IN(1)) REPS(1) { RELOAD_ARGS();
        pg8::GridOrder S{(const char*)(ws + WS_H), (const char*)(ws + WS_WIN), 1024, NTOK / 256, 2048 / 256, F.G, F.vcu, 0};
        pg8::EpiInprojMfma E{EpiInproj{(bf16_t*)(ws + WS_PROJ), (bf16_t*)(ws + WS_CQ), (bf16_t*)(ws + WS_CKV), (float*)(ws + WS_DT), (bf16_t*)(ws + WS_K), (const float*)(ws + WS_ROPEC), (const float*)(ws + WS_ROPES)},
                             (float*)(ws + WS_PARTQ), (float*)(ws + WS_PARTKV), (LAS float*)(F.lds + LDSCTL_OFF + 1024)};
        pg8::gemm_phase(F.lds, 1024, S, E);
    } SEAM(1);
    if (IN(2)) { RELOAD_ARGS();
        {
        REPS(22) { pg8::GridOrderRot S{(const char*)(ws + WS_CQ), (const char*)(ws + WS_WUQ), 256, NTOK / 256, 3, F.G, F.vcu, 0};
          pg8::EpiRows<EpiQ> E{EpiQ{(bf16_t*)(ws + WS_Q), (const float*)(ws + WS_PARTQ), (const float*)(ws + WS_ROPEC), (const float*)(ws + WS_ROPES)}};
          pg8::gemm_phase(F.lds, 256, S, E); }
        REPS(23) { pg8::GridOrderRot S{(const char*)(ws + WS_CKV), (const char*)(ws + WS_WKN), 128, NTOK / 256, 2, F.G, F.vcu, 192};
          pg8::EpiRows<EpiKn> E{EpiKn{(bf16_t*)(ws + WS_K), (const float*)(ws + WS_PARTKV)}};
          pg8::gemm_phase(F.lds, 128, S, E); }
        REPS(24) { pg8::GridOrderRot S{(const char*)(ws + WS_WV), (const char*)(ws + WS_CKV), 128, 2, NTOK / 256, F.G, F.vcu, 64};
          pg8::EpiColsVt E{(bf16_t*)(ws + WS_VT), (const float*)(ws + WS_PARTKV)};
          pg8::gemm_phase(F.lds, 128, S, E); }
        }
        REPS(21) for (int u = F.vcu; u < NB * 64 * NH; u += F.G)
            ssd::chunk_unit(F.lds, u >> 9, (u >> 3) & 63, u & 7, (const bf16_t*)(ws + WS_PROJ), (const float*)(ws + WS_DT), (const float*)KARG(kap, 4), (const float*)KARG(kap, 5), (const float*)KARG(kap, 6), (const float*)KARG(kap, 7), (const float*)KARG(kap, 8),
                            (float*)(ws + WS_Y), (float*)(ws + WS_STATES), (float*)(ws + WS_CD));
    } SEAM(2);
    if (IN(3)) REPS(3) { RELOAD_ARGS(); ssd::scan_phase(F.vcu, F.G, (const float*)(ws + WS_STATES), (float*)(ws + WS_PREV), (const float*)(ws + WS_CD)); } SEAM(3);
    if (IN(4)) { RELOAD_ARGS();
        REPS(40) for (int u = F.vcu; u < NB * 64 * NG; u += F.G)
            ssd::final_unit(F.lds, u >> 7, (u >> 1) & 63, u & 1, (const bf16_t*)(ws + WS_PROJ), (const float*)(ws + WS_DT), (const float*)KARG(kap, 4), (const float*)KARG(kap, 5), (const float*)KARG(kap, 6), (const float*)KARG(kap, 7), (const float*)KARG(kap, 9),
                            (const float*)(ws + WS_Y), (const float*)(ws + WS_PREV), (bf16_t*)(ws + WS_YCAT));
        REPS(41) att::attn_phase(F.lds, F.vcu, F.G, (const bf16_t*)(ws + WS_Q), (const bf16_t*)(ws + WS_K), (const bf16_t*)(ws + WS_VT), (bf16_t*)(ws + WS_YCAT));
    } SEAM(4);
    if (IN(5)) REPS(5) { RELOAD_ARGS();
        pg8::GridOrder S{(const char*)(ws + WS_YCAT), (const char*)(ws + WS_WOUT), 1024, NTOK / 256, 4, F.G, F.vcu, 0};
        pg8::EpiRows<EpiOut> E{EpiOut{(const float*)KARG(kap, 0), (float*)(ws + WS_X1)}};
        pg8::gemm_phase(F.lds, 1024, S, E);
    } SEAM(5);
    if (IN(6)) REPS(6) { RELOAD_ARGS(); const size_t dm = (PROBE_REP == 6 && rep_ == 1) ? 4 * MiB : 0;
                 router_phase(F.lds, F.vcu, F.G, (const float*)(ws + WS_X1), (const float*)KARG(kap, 15), (const float*)KARG(kap, 16), (const float*)KARG(kap, 17), (unsigned char*)(ws + WS_H2),
                              (u32*)(ctl + CW_CNT + (dm ? 8192 : 0)), (int*)(ws + (dm ? WS_END : WS_LIST)), (float*)(ws + (dm ? WS_END + 2 * MiB : WS_LISTG)), (int*)(ws + (dm ? WS_END + 4 * MiB : WS_TOKE)), (int*)(ws + (dm ? WS_END + 5 * MiB : WS_TOKP))); } SEAM(6);
    if (IN(7)) REPS(7) { RELOAD_ARGS();
        g8::MoeOrder<true> S{(const char*)(ws + WS_H2), (const char*)(ws + WS_WGU), (const u32*)(ctl + CW_CNT), (const int*)(ws + WS_LIST), 1024, 8, 2048, F.G, F.vcu, 0};
        g8::EpiMoeGlu E{(unsigned char*)(ws + WS_ACT), (const float*)KARG(kap, 19)};
        g8::gemm_phase(F.lds, 1024, S, E);
    } SEAM(7);
    if (IN(8)) REPS(8) { RELOAD_ARGS();
        g8::MoeOrder<false> S{(const char*)(ws + WS_ACT), (const char*)(ws + WS_WDN), (const u32*)(ctl + CW_CNT), (const int*)(ws + WS_LIST), 1024, 4, 1024, F.G, F.vcu, 0};
        g8::EpiMoeDown E{(bf16_t*)(ws + WS_YS), (const float*)KARG(kap, 21), (const float*)(ws + WS_LISTG)};
        g8::gemm_phase(F.lds, 1024, S, E);
    } SEAM(8);
    if (IN(9)) REPS(9) { RELOAD_ARGS(); combine_phase(F.vcu * NWAVES + F.wave, F.G * NWAVES, F.lane, (const float*)(ws + WS_X1), (const bf16_t*)(ws + WS_YS), (const u32*)(ctl + CW_CNT), (const int*)(ws + WS_TOKE), (const int*)(ws + WS_TOKP), (const float*)KARG(kap, 22), (float*)KARG(kap, 23)); }
#undef IN
#undef SEAM
}

static int g_grid = 0;
static void launch_mega(Args a, int lo, int hi, hipStream_t s) { a.ph_lo = lo; a.ph_hi = hi; hipLaunchKernelGGL(mega, dim3(g_grid), dim3(NTHR), LDS_BYTES, s, a); }
extern "C" void kernel_launch(void* const* d_in, const int* in_sizes, int n_in, void* d_out, int out_size, void* d_ws, size_t ws_size, hipStream_t stream) {
    if (n_in != 23 || in_sizes[0] != NTOK * DM || out_size != NTOK * DM || ws_size < WS_END) { fprintf(stderr, "kernel_launch: unexpected shapes (n_in %d, ws %zu)\n", n_in, ws_size); return; }
    if (g_grid == 0) {
        int dev = 0, cus = 0;
        if (hipGetDevice(&dev) != hipSuccess || hipDeviceGetAttribute(&cus, hipDeviceAttributeMultiprocessorCount, dev) != hipSuccess) { fprintf(stderr, "kernel_launch: device query failed\n"); g_grid = -1; return; }
        if (hipFuncSetAttribute((const void*)mega, hipFuncAttributeMaxDynamicSharedMemorySize, LDS_BYTES) != hipSuccess) { fprintf(stderr, "kernel_launch: hipFuncSetAttribute failed\n"); g_grid = -1; return; }
        (void)hipGetLastError();
        g_grid = cus;
    }
    if (g_grid < 0) return;
    const float* x = (const float*)d_in[0];
    const float* conv_w = (const float*)d_in[4]; const float* conv_b = (const float*)d_in[5]; const float* dt_bias = (const float*)d_in[6]; const float* a_log = (const float*)d_in[7];
    const float* d_skip = (const float*)d_in[8]; const float* ssd_norm_g = (const float*)d_in[9]; const float* q_norm_g = (const float*)d_in[10]; const float* w_uq = (const float*)d_in[11];
    const float* kv_norm_g = (const float*)d_in[12]; const float* w_ukv = (const float*)d_in[13]; const float* w_out = (const float*)d_in[14]; const float* norm_ffn_g = (const float*)d_in[15];
    const float* w_router = (const float*)d_in[16]; const float* b_router = (const float*)d_in[17]; const float* w_gate_up = (const float*)d_in[18]; const float* b_gate_up = (const float*)d_in[19];
    const float* w_down = (const float*)d_in[20]; const float* b_down = (const float*)d_in[21]; const float* norm_final_g = (const float*)d_in[22];
    char* ws = (char*)d_ws; float* out = (float*)d_out;
    u32* ctl = (u32*)(ws + WS_CTL); float* ropec = (float*)(ws + WS_ROPEC); float* ropes = (float*)(ws + WS_ROPES);
    bf16_t* PROJ = (bf16_t*)(ws + WS_PROJ); bf16_t* CQ = (bf16_t*)(ws + WS_CQ); bf16_t* CKV = (bf16_t*)(ws + WS_CKV);
    float* DT = (float*)(ws + WS_DT); float* PARTQ = (float*)(ws + WS_PARTQ); float* PARTKV = (float*)(ws + WS_PARTKV);
    bf16_t* Qb = (bf16_t*)(ws + WS_Q); bf16_t* Kb = (bf16_t*)(ws + WS_K); bf16_t* VTb = (bf16_t*)(ws + WS_VT);
    float* Y = (float*)(ws + WS_Y); bf16_t* YCAT = (bf16_t*)(ws + WS_YCAT); float* X1 = (float*)(ws + WS_X1); bf16_t* H2 = (bf16_t*)(ws + WS_H2);
    int* TOKE = (int*)(ws + WS_TOKE); int* TOKP = (int*)(ws + WS_TOKP); int* LIST = (int*)(ws + WS_LIST); float* LISTG = (float*)(ws + WS_LISTG);
    bf16_t* ACT = (bf16_t*)(ws + WS_ACT); bf16_t* YS = (bf16_t*)(ws + WS_YS); float* XBCC = (float*)(ws + WS_XBCC);
    Args a{}; for (int i = 0; i < 23; ++i) a.in[i] = d_in[i]; a.out = out; a.ws = (unsigned char*)d_ws;

    (void)hipMemsetAsync(ws + WS_CTL, 0, CTL_BYTES, stream);
    launch_mega(a, 0, 10, stream);
}
```
